# Optimizing an MI355X kernel written in HIP

```python
import numpy as np
import jax
import jax.numpy as jnp
from jax import lax

D_MODEL = 2048
BATCH = 4
SEQ = 4096
DEPTH = 2

HEAD_DIM = 128
MIX_WIDTH = D_MODEL
NSA_WIDTH = MIX_WIDTH // 2
GLA_WIDTH = MIX_WIDTH - NSA_WIDTH
NSA_HEADS = NSA_WIDTH // HEAD_DIM
NSA_KV_HEADS = NSA_HEADS // 4
NSA_GROUP = NSA_HEADS // NSA_KV_HEADS
CMP_BLOCK = 32
CMP_STRIDE = 16
CMP_HIDDEN = 256
SLC_BLOCK = 64
SLC_TOPN = 16
WINDOW = 512
NSA_QBLOCK = 64
FORCE_SCORE = 1e9
GLA_DV = 256
GLA_HEADS = GLA_WIDTH // GLA_DV
GLA_DK = GLA_DV // 2
GLA_GATE_RANK = 16
GLA_GATE_NORM = 16.0
GLA_CHUNK = 64
ROPE_THETA = 500000.0
ROPE_DIMS = HEAD_DIM // 4
D_FF = 256 * ((8 * D_MODEL // 3 + 255) // 256)
N_EXPERTS = 8
TOP_K = 2
D_FF_EXPERT = 7 * D_MODEL // 2
MOE_BLOCK = 512
N_DENSE = (DEPTH + 1) // 2
N_MOE = DEPTH // 2
LN_EPS = 1e-5
NORM_EPS = 1e-6
DEEPNORM_ALPHA = (2 * DEPTH) ** 0.25
DEEPNORM_BETA = (8 * DEPTH) ** -0.25
ADA_INIT_SCALE = 0.1
SPLIT_SIZES = (NSA_HEADS * HEAD_DIM,) + (NSA_KV_HEADS * HEAD_DIM,) * 6 + (NSA_HEADS * 3, GLA_HEADS * GLA_DK, GLA_HEADS * GLA_DK, GLA_HEADS * GLA_DV, GLA_GATE_RANK, GLA_HEADS * GLA_DV)
IN_WIDTH = sum(SPLIT_SIZES)

kernel_name = 'hybrid_nsa_gla_moe_deepnorm_adaln'


def layer_norm(x, g, b):
    xf = x.astype(jnp.float32)
    mu = jnp.mean(xf, axis=-1, keepdims=True)
    var = jnp.mean(jnp.square(xf - mu), axis=-1, keepdims=True)
    return ((xf - mu) * lax.rsqrt(var + LN_EPS) * g + b).astype(x.dtype)


def rotary_partial(x, pos):
    half = ROPE_DIMS // 2
    inv = ROPE_THETA ** (-jnp.arange(half, dtype=jnp.float32) * 2.0 / ROPE_DIMS)
    ang = pos.astype(jnp.float32)[:, None] * inv[None, :]
    cos = jnp.cos(ang)[:, None, :]
    sin = jnp.sin(ang)[:, None, :]
    x1 = x[..., :half].astype(jnp.float32)
    x2 = x[..., half:ROPE_DIMS].astype(jnp.float32)
    r1 = (x1 * cos - x2 * sin).astype(x.dtype)
    r2 = (x2 * cos + x1 * sin).astype(x.dtype)
    return jnp.concatenate([r1, r2, x[..., ROPE_DIMS:]], axis=-1)


def masked_softmax(s, mask):
    s = jnp.where(mask, s.astype(jnp.float32), -1e30)
    p = jax.nn.softmax(s, axis=-1)
    return jnp.where(mask, p, 0.0)


def nsa_attention(q, k_cmp, v_cmp, k_slc, v_slc, k_win, v_win, gates,
                  cmp_pos_k, cmp_w1_k, cmp_w2_k, cmp_pos_v, cmp_w1_v, cmp_w2_v):
    B, T = q.shape[0], q.shape[1]
    dt = q.dtype
    Hkv, G, Dh, QB = NSA_KV_HEADS, NSA_GROUP, HEAD_DIM, NSA_QBLOCK
    pos = jnp.arange(T)
    scale = HEAD_DIM ** -0.5

    n_cmp = (T - CMP_BLOCK) // CMP_STRIDE + 1
    cmp_idx = jnp.arange(n_cmp)[:, None] * CMP_STRIDE + jnp.arange(CMP_BLOCK)[None, :]

    def compress(a, pe, w1, w2):
        blocks = a[:, cmp_idx] + pe[None, None, :, None, :]
        blocks = blocks.transpose(0, 1, 3, 2, 4).reshape(B, n_cmp, Hkv, CMP_BLOCK * Dh)
        return jax.nn.gelu(blocks @ w1) @ w2

    kc = compress(k_cmp, cmp_pos_k, cmp_w1_k, cmp_w2_k)
    vc = compress(v_cmp, cmp_pos_v, cmp_w1_v, cmp_w2_v)
    cmp_start = jnp.arange(n_cmp) * CMP_STRIDE
    cmp_end = cmp_start + CMP_BLOCK - 1

    n_slc = T // SLC_BLOCK
    n_sel = min(SLC_TOPN, n_slc)
    blk_start = jnp.arange(n_slc) * SLC_BLOCK
    overlap = ((cmp_start[:, None] < blk_start[None, :] + SLC_BLOCK)
               & (cmp_start[:, None] + CMP_BLOCK > blk_start[None, :])).astype(jnp.float32)

    q_rot = rotary_partial(q, pos) * scale
    q_nope = q * scale
    k_blocks = rotary_partial(k_slc, pos).reshape(B, n_slc, SLC_BLOCK, Hkv, Dh).transpose(0, 3, 1, 2, 4)
    v_blocks = v_slc.reshape(B, n_slc, SLC_BLOCK, Hkv, Dh).transpose(0, 3, 1, 2, 4)
    pad = ((0, 0), (WINDOW, 0), (0, 0), (0, 0))
    kw = jnp.pad(rotary_partial(k_win, pos), pad)
    vw = jnp.pad(v_win, pad)
    gate = jax.nn.sigmoid(gates.astype(jnp.float32))

    n_qb = T // QB
    bi = jnp.arange(B)[:, None, None, None]
    hi = jnp.arange(Hkv)[None, :, None, None]
    j_blk = jnp.arange(n_slc)

    def to_blocks(a):
        return a.reshape((B, n_qb, QB) + a.shape[2:]).swapaxes(0, 1)

    def block_fn(args):
        i, qr, qn, g = args
        t = i * QB + jnp.arange(QB)
        qr = qr.reshape(B, QB, Hkv, G, Dh)
        qn = qn.reshape(B, QB, Hkv, G, Dh)
        s_c = jnp.einsum('bqhgd,bchd->bhgqc', qn, kc)
        p_c = masked_softmax(s_c, cmp_end[None, :] <= t[:, None])
        o_c = jnp.einsum('bhgqc,bchd->bqhgd', p_c.astype(dt), vc)
        imp = jnp.einsum('bhgqc,cn->bhqn', p_c, overlap)
        cur = t // SLC_BLOCK
        forced = (j_blk[None, :] == 0) | (j_blk[None, :] == cur[:, None]) | (j_blk[None, :] == cur[:, None] - 1)
        future = blk_start[None, :] > t[:, None]
        imp = jnp.where(future, -jnp.inf, jnp.where(forced, FORCE_SCORE, imp))
        _, sel = lax.top_k(imp, n_sel)
        k_sel = k_blocks[bi, hi, sel]
        v_sel = v_blocks[bi, hi, sel]
        s_s = jnp.einsum('bqhgd,bhqnkd->bhgqnk', qr, k_sel)
        key_pos = sel[..., None] * SLC_BLOCK + jnp.arange(SLC_BLOCK)
        mask_s = (key_pos <= t[None, None, :, None, None]).reshape(B, Hkv, 1, QB, n_sel * SLC_BLOCK)
        p_s = masked_softmax(s_s.reshape(B, Hkv, G, QB, n_sel * SLC_BLOCK), mask_s).reshape(s_s.shape)
        o_s = jnp.einsum('bhgqnk,bhqnkd->bqhgd', p_s.astype(dt), v_sel)
        start = i * QB
        k_band = lax.dynamic_slice_in_dim(kw, start, WINDOW + QB, axis=1)
        v_band = lax.dynamic_slice_in_dim(vw, start, WINDOW + QB, axis=1)
        wpos = start - WINDOW + jnp.arange(WINDOW + QB)
        diff = t[:, None] - wpos[None, :]
        mask_w = (wpos[None, :] >= 0) & (diff >= 0) & (diff < WINDOW)
        s_w = jnp.einsum('bqhgd,bkhd->bhgqk', qr, k_band)
        p_w = masked_softmax(s_w, mask_w)
        o_w = jnp.einsum('bhgqk,bkhd->bqhgd', p_w.astype(dt), v_band)
        g = g.reshape(B, QB, Hkv, G, 3)
        o = g[..., 0:1] * o_c + g[..., 1:2] * o_s + g[..., 2:3] * o_w
        return o.reshape(B, QB, NSA_HEADS * Dh).astype(dt)

    out = lax.map(block_fn, (jnp.arange(n_qb), to_blocks(q_rot), to_blocks(q_nope), to_blocks(gate)))
    return out.swapaxes(0, 1).reshape(B, T, NSA_HEADS * Dh)


def gla_chunked(q, k, v, log_a):
    B, T, H, Dk = q.shape
    Dv = v.shape[-1]
    C = GLA_CHUNK
    n = T // C

    def chunks(a):
        return a.astype(jnp.float32).reshape(B, n, C, H, a.shape[-1])

    qf = chunks(q) * (Dk ** -0.5)
    kf = chunks(k)
    vf = chunks(v)
    b = jnp.cumsum(chunks(log_a), axis=2)
    b_last = b[:, :, -1]
    q_dec = qf * jnp.exp(b)
    k_intra = kf * jnp.exp(-b)
    k_state = kf * jnp.exp(b_last[:, :, None] - b)
    causal = jnp.tril(jnp.ones((C, C), dtype=bool))
    A = jnp.where(causal, jnp.einsum('bnihd,bnjhd->bnhij', q_dec, k_intra), 0.0)
    o_intra = jnp.einsum('bnhij,bnjhe->bnihe', A, vf)

    def step(S, inp):
        qd, ksd, vv, bl = inp
        o = jnp.einsum('bihd,bhde->bihe', qd, S)
        S = S * jnp.exp(bl)[..., None] + jnp.einsum('bjhd,bjhe->bhde', ksd, vv)
        return S, o

    S0 = jnp.zeros((B, H, Dk, Dv), jnp.float32)
    _, o_inter = lax.scan(step, S0, (q_dec.swapaxes(0, 1), k_state.swapaxes(0, 1), vf.swapaxes(0, 1), b_last.swapaxes(0, 1)))
    o = o_intra + o_inter.swapaxes(0, 1)
    return o.reshape(B, T, H, Dv)


def hybrid_mixer(h, w_in, cmp_pos_k, cmp_w1_k, cmp_w2_k, cmp_pos_v, cmp_w1_v, cmp_w2_v,
                 gla_w_a2, gla_b_a, gla_norm_w, w_out):
    B, T, _ = h.shape
    idx = np.cumsum(SPLIT_SIZES)[:-1].tolist()
    (nq, kc, vc, ks, vs, kw, vw, ng, gq, gk, gv, ga, gg) = jnp.split(h @ w_in, idx, axis=-1)

    def heads(a, n_h):
        return a.reshape(B, T, n_h, a.shape[-1] // n_h)

    nsa_out = nsa_attention(heads(nq, NSA_HEADS), heads(kc, NSA_KV_HEADS), heads(vc, NSA_KV_HEADS),
                            heads(ks, NSA_KV_HEADS), heads(vs, NSA_KV_HEADS), heads(kw, NSA_KV_HEADS),
                            heads(vw, NSA_KV_HEADS), heads(ng, NSA_HEADS),
                            cmp_pos_k, cmp_w1_k, cmp_w2_k, cmp_pos_v, cmp_w1_v, cmp_w2_v)
    log_a = jax.nn.log_sigmoid((ga @ gla_w_a2 + gla_b_a).astype(jnp.float32)) / GLA_GATE_NORM
    o = gla_chunked(heads(gq, GLA_HEADS), heads(gk, GLA_HEADS), heads(gv, GLA_HEADS), heads(log_a, GLA_HEADS))
    o = o * lax.rsqrt(jnp.mean(jnp.square(o), axis=-1, keepdims=True) + NORM_EPS) * gla_norm_w
    gla_out = (o * jax.nn.silu(heads(gg, GLA_HEADS).astype(jnp.float32))).reshape(B, T, GLA_WIDTH).astype(h.dtype)
    return jnp.concatenate([nsa_out, gla_out], axis=-1) @ w_out


def swiglu(h, w_gate, w_up, w_down):
    return (jax.nn.silu(h @ w_gate) * (h @ w_up)) @ w_down


def moe_swiglu(h, w_router, w_gate, w_up, w_down):
    B, T, D = h.shape
    xt = h.reshape(-1, D)
    N = xt.shape[0]
    A = N * TOP_K
    logits = (xt @ w_router).astype(jnp.float32)
    top_val, top_idx = lax.top_k(logits, TOP_K)
    comb = jax.nn.softmax(top_val, axis=-1)
    flat_e = top_idx.reshape(-1).astype(jnp.int32)
    flat_tok = jnp.repeat(jnp.arange(N, dtype=jnp.int32), TOP_K)
    order = jnp.argsort(flat_e)
    e_sorted = flat_e[order]
    tok_sorted = flat_tok[order]
    w_sorted = comb.reshape(-1)[order]
    counts = jnp.bincount(flat_e, length=N_EXPERTS)
    padded = (counts + MOE_BLOCK - 1) // MOE_BLOCK * MOE_BLOCK
    pad_end = jnp.cumsum(padded)
    pad_start = pad_end - padded
    seg_start = jnp.cumsum(counts) - counts
    dest = pad_start[e_sorted] + jnp.arange(A, dtype=jnp.int32) - seg_start[e_sorted]
    n_blocks = -(-A // MOE_BLOCK) + N_EXPERTS
    slot_tok = jnp.full((n_blocks * MOE_BLOCK,), N, jnp.int32).at[dest].set(tok_sorted)
    block_e = jnp.minimum(jnp.searchsorted(pad_end, jnp.arange(n_blocks) * MOE_BLOCK, side='right'), N_EXPERTS - 1)
    x_pad = jnp.concatenate([xt, jnp.zeros((1, D), xt.dtype)], axis=0)

    def expert_block(args):
        tok, e = args
        xb = x_pad[tok]
        return (jax.nn.silu(xb @ w_gate[e]) * (xb @ w_up[e])) @ w_down[e]

    y = lax.map(expert_block, (slot_tok.reshape(n_blocks, MOE_BLOCK), block_e)).reshape(-1, D)
    y_assign = y[dest] * w_sorted[:, None].astype(y.dtype)
    out = jax.ops.segment_sum(y_assign, tok_sorted, num_segments=N)
    return out.reshape(B, T, D)


def setup_inputs(seed: int = 0) -> dict:
    key = jax.random.key(seed)
    ks = jax.random.split(key, 26)
    L, D = DEPTH, D_MODEL

    def nrm(k, shape, s):
        return jax.random.normal(k, shape, jnp.float32) * s

    return {
        'x': nrm(ks[0], (BATCH, SEQ, D), 1.0),
        'c': nrm(ks[1], (BATCH, D), 1.0),
        'w_ada': nrm(ks[2], (L, D, 6 * D), ADA_INIT_SCALE * D ** -0.5),
        'b_ada': nrm(ks[3], (L, 6 * D), 0.01),
        'w_in': nrm(ks[4], (L, D, IN_WIDTH), D ** -0.5),
        'cmp_pos_k': nrm(ks[5], (L, CMP_BLOCK, HEAD_DIM), 0.02),
        'cmp_w1_k': nrm(ks[6], (L, CMP_BLOCK * HEAD_DIM, CMP_HIDDEN), (CMP_BLOCK * HEAD_DIM) ** -0.5),
        'cmp_w2_k': nrm(ks[7], (L, CMP_HIDDEN, HEAD_DIM), CMP_HIDDEN ** -0.5),
        'cmp_pos_v': nrm(ks[8], (L, CMP_BLOCK, HEAD_DIM), 0.02),
        'cmp_w1_v': nrm(ks[9], (L, CMP_BLOCK * HEAD_DIM, CMP_HIDDEN), (CMP_BLOCK * HEAD_DIM) ** -0.5),
        'cmp_w2_v': nrm(ks[10], (L, CMP_HIDDEN, HEAD_DIM), CMP_HIDDEN ** -0.5),
        'gla_w_a2': nrm(ks[11], (L, GLA_GATE_RANK, GLA_HEADS * GLA_DK), GLA_GATE_RANK ** -0.5),
        'gla_b_a': nrm(ks[12], (L, GLA_HEADS * GLA_DK), 0.01),
        'gla_norm_w': 1.0 + nrm(ks[13], (L, GLA_DV), 0.02),
        'w_out': nrm(ks[14], (L, MIX_WIDTH, D), DEEPNORM_BETA * MIX_WIDTH ** -0.5),
        'ln_mix_g': 1.0 + nrm(ks[15], (L, D), 0.02),
        'ln_mix_b': nrm(ks[16], (L, D), 0.02),
        'ln_ffn_g': 1.0 + nrm(ks[17], (L, D), 0.02),
        'ln_ffn_b': nrm(ks[18], (L, D), 0.02),
        'ffn_w_gate': nrm(ks[19], (N_DENSE, D, D_FF), D ** -0.5),
        'ffn_w_up': nrm(ks[20], (N_DENSE, D, D_FF), D ** -0.5),
        'ffn_w_down': nrm(ks[21], (N_DENSE, D_FF, D), DEEPNORM_BETA * D_FF ** -0.5),
        'moe_router': nrm(ks[22], (N_MOE, D, N_EXPERTS), D ** -0.5),
        'moe_w_gate': nrm(ks[23], (N_MOE, N_EXPERTS, D, D_FF_EXPERT), D ** -0.5),
        'moe_w_up': nrm(ks[24], (N_MOE, N_EXPERTS, D, D_FF_EXPERT), D ** -0.5),
        'moe_w_down': nrm(ks[25], (N_MOE, N_EXPERTS, D_FF_EXPERT, D), DEEPNORM_BETA * D_FF_EXPERT ** -0.5),
    }


def reference(x, c, w_ada, b_ada, w_in, cmp_pos_k, cmp_w1_k, cmp_w2_k, cmp_pos_v, cmp_w1_v, cmp_w2_v,
              gla_w_a2, gla_b_a, gla_norm_w, w_out, ln_mix_g, ln_mix_b, ln_ffn_g, ln_ffn_b,
              ffn_w_gate, ffn_w_up, ffn_w_down, moe_router, moe_w_gate, moe_w_up, moe_w_down):
    cond = jax.nn.silu(c)
    for layer in range(DEPTH):
        mod = cond @ w_ada[layer] + b_ada[layer]
        sh_a, sc_a, g_a, sh_f, sc_f, g_f = jnp.split(mod, 6, axis=-1)
        h = x * (1.0 + sc_a[:, None, :]) + sh_a[:, None, :]
        y = hybrid_mixer(h, w_in[layer], cmp_pos_k[layer], cmp_w1_k[layer], cmp_w2_k[layer],
                         cmp_pos_v[layer], cmp_w1_v[layer], cmp_w2_v[layer],
                         gla_w_a2[layer], gla_b_a[layer], gla_norm_w[layer], w_out[layer])
        x = layer_norm(DEEPNORM_ALPHA * x + (1.0 + g_a[:, None, :]) * y, ln_mix_g[layer], ln_mix_b[layer])
        h = x * (1.0 + sc_f[:, None, :]) + sh_f[:, None, :]
        if layer % 2 == 0:
            i = layer // 2
            y = swiglu(h, ffn_w_gate[i], ffn_w_up[i], ffn_w_down[i])
        else:
            i = layer // 2
            y = moe_swiglu(h, moe_router[i], moe_w_gate[i], moe_w_up[i], moe_w_down[i])
        x = layer_norm(DEEPNORM_ALPHA * x + (1.0 + g_f[:, None, :]) * y, ln_ffn_g[layer], ln_ffn_b[layer])
    return x
```

```cpp
#include <hip/hip_runtime.h>
#include <cstdio>
#include <cstdint>

#ifndef ONE_LAUNCH
#define ONE_LAUNCH 1
#endif
#ifndef FAST_GEMM
#define FAST_GEMM 1
#endif
#ifndef FAST_NSA
#define FAST_NSA 1
#endif
#ifndef FAST_CMP
#define FAST_CMP 1
#endif
#ifndef FAST_GLA
#define FAST_GLA 1
#endif

#define GAS __attribute__((address_space(1)))
#define LAS __attribute__((address_space(3)))
typedef unsigned short bf16;
typedef float f32x4 __attribute__((ext_vector_type(4)));
typedef float f32x2 __attribute__((ext_vector_type(2)));
typedef unsigned u32x4 __attribute__((ext_vector_type(4)));
typedef unsigned u32x2 __attribute__((ext_vector_type(2)));

constexpr int NB = 4, T = 4096, M = NB * T, D = 2048, D6 = 6 * D;
constexpr int INW = 5672, PW = 5888;
constexpr int PQ = 0, PKC = 1024, PVC = 1280, PKS = 1536, PVS = 1792, PKW = 2048, PVW = 2304, PGQ = 2560, PGK = 3072, PGV = 3584, PGG = 4608, PNG = 5632, PGA = 5656;
constexpr int DFF = 5632, DFE = 7168, NE = 8;
constexpr int MOE_ROWS = 2 * M + NE * 256;
constexpr float LN_EPS = 1e-5f, NORM_EPS = 1e-6f, ALPHA = 1.4142135623730951f, QSCALE = 0.08838834764831845f;
constexpr int NCR = 2048;

constexpr size_t MiB = 1u << 20;
constexpr size_t WS_CTL = 0, CTL_ZERO_BYTES = 1 * MiB;
constexpr size_t WS_MOD = 1 * MiB;
constexpr size_t WS_ROPE = 2 * MiB;
constexpr size_t WS_KC = 3 * MiB;
constexpr size_t WS_CHID = 5 * MiB;
constexpr size_t WS_ROUTE = 10 * MiB;
constexpr size_t WS_LA = 12 * MiB;
constexpr size_t WS_XA = 44 * MiB;
constexpr size_t WS_PROJ = 172 * MiB;
constexpr size_t WS_MIX = 356 * MiB;
constexpr size_t WS_GLAO = 420 * MiB;
constexpr size_t WS_HID = 172 * MiB;
constexpr size_t WS_HPERM = 648 * MiB;
constexpr size_t WS_Y = 784 * MiB;
constexpr size_t WS_END = 1056 * MiB;
static_assert(WS_HID + (size_t)MOE_ROWS * DFE * 2 <= WS_HPERM && WS_HPERM + (size_t)MOE_ROWS * D * 2 <= WS_Y && WS_Y + (size_t)MOE_ROWS * D * 4 <= WS_END, "ws map");
static_assert(WS_PROJ + (size_t)M * PW * 2 <= WS_MIX && WS_MIX + (size_t)M * 2048 * 2 <= WS_GLAO && WS_GLAO + (size_t)M * 1024 * 4 <= WS_HPERM, "ws map 2");

constexpr int VTP = 4096 + 64;
constexpr size_t WS_VTS = 1856 * MiB;
constexpr size_t WS_VTW = 1865 * MiB;
constexpr size_t WS_KCB = 1874 * MiB;
constexpr size_t WS_VCT = 1875 * MiB;
constexpr size_t WS_CW1T = 1876 * MiB;
constexpr size_t WS_CW2T = 1885 * MiB;
constexpr size_t WS_CPART = 1886 * MiB;
constexpr size_t WS_CHIDB = 1887 * MiB;
constexpr size_t WS_END3 = 1889 * MiB;
static_assert(WS_VTS + (size_t)8 * 128 * VTP * 2 <= WS_VTW && WS_VTW + (size_t)8 * 128 * VTP * 2 <= WS_KCB && WS_CW1T + (size_t)4 * 256 * VTP * 2 <= WS_CW2T, "tail map");
constexpr int CW_BAR = 4096;

constexpr int SCR_BYTES = 148480;
constexpr int MISC_OFF = SCR_BYTES;
constexpr int LDS_BYTES = SCR_BYTES + 1024;

__device__ __forceinline__ unsigned f2bf(float f) { unsigned u = __builtin_bit_cast(unsigned, f); return (u + 0x7fffu + ((u >> 16) & 1u)) >> 16; }
__device__ __forceinline__ unsigned pk2(float lo, float hi) { return f2bf(lo) | (f2bf(hi) << 16); }
__device__ __forceinline__ float bflo(unsigned w) { return __builtin_bit_cast(float, w << 16); }
__device__ __forceinline__ float bfhi(unsigned w) { return __builtin_bit_cast(float, w & 0xffff0000u); }
__device__ __forceinline__ float bf1(bf16 b) { return __builtin_bit_cast(float, ((unsigned)b) << 16); }
__device__ __forceinline__ float wave_sum(float v) {
#pragma unroll
    for (int o = 1; o < 64; o <<= 1) v += __shfl_xor(v, o);
    return v;
}
__device__ __forceinline__ float wave_max(float v) {
#pragma unroll
    for (int o = 1; o < 64; o <<= 1) v = fmaxf(v, __shfl_xor(v, o));
    return v;
}
__device__ __forceinline__ float sigmoidf_(float x) { return 1.f / (1.f + __expf(-x)); }
__device__ __forceinline__ float siluf_(float x) { return x / (1.f + __expf(-x)); }
__device__ __forceinline__ float gelu_tanh(float x) { const float u = 0.7978845608028654f * (x + 0.044715f * x * x * x); const float e = __expf(2.f * u); const float th = 1.f - 2.f / (e + 1.f); return 0.5f * x * (1.f + th); }

__device__ __forceinline__ f32x4 ld_bf4(const bf16* p) { const u32x2 w = *(const u32x2*)p; return (f32x4){bflo(w.x), bfhi(w.x), bflo(w.y), bfhi(w.y)}; }
__device__ __forceinline__ void st_bf4(bf16* p, f32x4 v) { u32x2 w; w.x = pk2(v.x, v.y); w.y = pk2(v.z, v.w); *(u32x2*)p = w; }
#ifndef XBF16
#define XBF16 1
#endif
#if XBF16
typedef bf16 XT; typedef u32x2 XRaw;
__device__ __forceinline__ XRaw ldxr(const XT* p) { return *(const u32x2*)p; }
__device__ __forceinline__ f32x4 xr2f(XRaw w) { return (f32x4){bflo(w.x), bfhi(w.x), bflo(w.y), bfhi(w.y)}; }
__device__ __forceinline__ void stx4(XT* p, f32x4 v) { st_bf4(p, v); }
#else
typedef float XT; typedef f32x4 XRaw;
__device__ __forceinline__ XRaw ldxr(const XT* p) { return *(const f32x4*)p; }
__device__ __forceinline__ f32x4 xr2f(XRaw w) { return w; }
__device__ __forceinline__ void stx4(XT* p, f32x4 v) { *(f32x4*)p = v; }
#endif

#define XB_TMO      128
#define XB_XCNT(j)  (256  + 64 * (j))
#define XB_XSUB(j)  (1280 + 64 * (j))
#define XB_XGEN(j)  (2304 + 64 * (j))
#define XB_TOP      3328
#define XB_TOPGEN   3392
#define XCD_BAR_WORDS 3456
#define XB_SPIN_CAP (1u << 22)
__device__ __forceinline__ unsigned xb_ld(unsigned* p)              { return __hip_atomic_load(p, __ATOMIC_RELAXED, __HIP_MEMORY_SCOPE_AGENT); }
__device__ __forceinline__ unsigned xb_add(unsigned* p, unsigned v) { return __hip_atomic_fetch_add(p, v, __ATOMIC_RELAXED, __HIP_MEMORY_SCOPE_AGENT); }
__device__ __forceinline__ unsigned xb_xcc_id() { return (unsigned)__builtin_amdgcn_s_getreg((3 << 11) | 20) & 0xFu; }
#define XB_SPIN(cond, bar) do { unsigned _sp = 0; while (cond) { __builtin_amdgcn_s_sleep(1); \
    if ((++_sp & 255u) == 0u) { if (xb_ld(&(bar)[XB_TMO])) break; if (_sp > XB_SPIN_CAP) { atomicAdd(&(bar)[XB_TMO], 1u); break; } } } } while (0)
struct XcdBarrier { unsigned* bar; unsigned x; volatile LAS unsigned* st; };
__device__ __forceinline__ XcdBarrier xcd_barrier_post(unsigned* bar, volatile LAS unsigned* st) {
    XcdBarrier b; b.bar = bar; b.x = xb_xcc_id(); b.st = st;
    if (threadIdx.x == 0) (void)xb_add(&bar[XB_XCNT(b.x)], 1u);
    return b;
}
__device__ __forceinline__ void xcd_barrier_complete(unsigned* bar, unsigned x, unsigned& nloc, unsigned& nx) {
    const unsigned G = gridDim.x * gridDim.y * gridDim.z;
    unsigned sum, cnt, mine, sp = 0u;
    for (;;) {
        sum = 0u; cnt = 0u; mine = 0u;
#pragma unroll
        for (unsigned j = 0; j < 16; ++j) { const unsigned c = xb_ld(&bar[XB_XCNT(j)]); sum += c; cnt += (c > 0u) ? 1u : 0u; mine = (j == x) ? c : mine; }
        if (sum == G) break;
        __builtin_amdgcn_s_sleep(1);
        if ((++sp & 255u) == 0u) { if (xb_ld(&bar[XB_TMO])) break; if (sp > XB_SPIN_CAP) { atomicAdd(&bar[XB_TMO], 1u); break; } }
    }
    nloc = mine > 0u ? mine : 1u; nx = cnt > 0u ? cnt : 1u;
}
__device__ __forceinline__ void xcd_barrier(const XcdBarrier& b) {
    asm volatile("s_waitcnt vmcnt(0)" ::: "memory");
    __syncthreads();
    if (threadIdx.x == 0) {
        unsigned* bar = b.bar;
        __builtin_amdgcn_s_waitcnt(0);
        unsigned nloc = b.st[0], nx = b.st[1];
        if (nloc == 0u) { xcd_barrier_complete(bar, b.x, nloc, nx); b.st[0] = nloc; b.st[1] = nx; }
        const unsigned old = xb_add(&bar[XB_XSUB(b.x)], 1u);
        const unsigned gen = old / nloc;
        if (old + 1u == (gen + 1u) * nloc) {
            __builtin_amdgcn_fence(__ATOMIC_RELEASE, "agent");
            asm volatile("s_waitcnt vmcnt(0)" ::: "memory");
            const unsigned og = xb_add(&bar[XB_TOP], 1u);
            const unsigned tg = og / nx;
            if (og + 1u == (tg + 1u) * nx) xb_add(&bar[XB_TOPGEN], 1u);
            else XB_SPIN(xb_ld(&bar[XB_TOPGEN]) == tg, bar);
            __builtin_amdgcn_fence(__ATOMIC_ACQUIRE, "agent");
            xb_add(&bar[XB_XGEN(b.x)], 1u);
            asm volatile("s_waitcnt vmcnt(0)" ::: "memory");
        } else {
            XB_SPIN(xb_ld(&bar[XB_XGEN(b.x)]) == gen, bar);
            __builtin_amdgcn_fence(__ATOMIC_ACQUIRE, "agent");
            asm volatile("s_waitcnt vmcnt(0)" ::: "memory");
        }
    }
    __syncthreads();
}

struct Args { const float* in[26]; float* out; unsigned char* ws; int ph_lo, ph_hi, pad0, pad1; };
enum { I_X = 0, I_C, I_WADA, I_BADA, I_WIN, I_CPK, I_CW1K, I_CW2K, I_CPV, I_CW1V, I_CW2V, I_GWA2, I_GBA, I_GNW, I_WOUT, I_LMG, I_LMB, I_LFG, I_LFB,
       I_FWG, I_FWU, I_FWD, I_MR, I_MWG, I_MWU, I_MWD };

namespace pg8 {
#define PG8_LAS __attribute__((address_space(3)))
typedef unsigned short bf16_t;
typedef short bf16x8 __attribute__((ext_vector_type(8)));
typedef float f32x4 __attribute__((ext_vector_type(4)));
typedef unsigned u32x4 __attribute__((ext_vector_type(4)));
constexpr int BM = 256, BK = 64, HALF = 128, HTB = HALF * BK * 2  , STAGE_BYTES = 8 * HTB, NXCD = 8, WGM = 8;

__host__ __device__ __forceinline__ int lds_byte(int r, int c) { const int st = (r >> 4) * 2 + (c >> 5), rr = r & 15, cc = c & 31, ob = rr * 64 + cc * 2; return st * 1024 + (ob ^ (((ob >> 9) & 1) << 5)); }
__host__ __device__ __forceinline__ void stage_rc(int b, int& R, int& C) { const int st = b / 1024, sb = b % 1024, swz = sb ^ (((sb >> 9) & 1) << 5); R = (st >> 1) * 16 + swz / 64; C = (st & 1) * 32 + (swz % 64) / 2; }
__host__ __device__ __forceinline__ int perm32(int rho) { const int n = rho >> 4, i = rho & 15; return 8 * (i >> 2) + 4 * n + (i & 3); }

struct Unit { int pm, pn, pb; };
struct Gemm { const bf16_t* A; const bf16_t* Bt; int M, N, K; };

struct StaticOrder {
    int nM, nN, nwg, G, c;
    __host__ __device__ void init(int M, int N, int G_, int c_) { nM = M / BM; nN = N / BM; nwg = nM * nN; G = G_; c = c_; }
    __host__ __device__ bool next(int i, Unit& u) const {
        const long L = (long)i * G + c; if (L >= nwg) return false;
        int wgid = (int)L; { const int q = nwg / NXCD, r = nwg % NXCD, xcd = wgid % NXCD, off = wgid / NXCD; wgid = (xcd < r ? xcd * (q + 1) : r * (q + 1) + (xcd - r) * q) + off; }
        const int nig = WGM * nN, gid = wgid / nig, fm = gid * WGM, gsz = (nM - fm) < WGM ? (nM - fm) : WGM;
        u.pm = fm + ((wgid % nig) % gsz); u.pn = (wgid % nig) / gsz; u.pb = u.pn; return true;
    }
    __device__ __forceinline__ void a_ready(const Unit&) const {}
    __device__ __forceinline__ void done(const Unit&) const {}
};

__device__ __forceinline__ unsigned cvt_pk_bf16(float lo, float hi) { unsigned r; asm volatile("v_cvt_pk_bf16_f32 %0, %1, %2" : "=v"(r) : "v"(lo), "v"(hi)); return r; }
typedef float f32x2 __attribute__((ext_vector_type(2)));

typedef int i32x8 __attribute__((ext_vector_type(8))); typedef int i32x4 __attribute__((ext_vector_type(4)));
__device__ __forceinline__ i32x8 cat8(bf16x8 lo, bf16x8 hi) { const i32x4 a = __builtin_bit_cast(i32x4, lo), b = __builtin_bit_cast(i32x4, hi); return (i32x8){a.x, a.y, a.z, a.w, b.x, b.y, b.z, b.w}; }
template <class Epi, class Sched, bool ALIGN_EPI = false, bool SP2 = false, bool FP8 = false>
__device__ __forceinline__ void gemm_phase(PG8_LAS unsigned char* lds, const Gemm g, const Sched& S, const Epi& E) {
    const int tid = threadIdx.x, wid = __builtin_amdgcn_readfirstlane(tid >> 6), lane = tid & 63, wr = wid >> 2, wc = wid & 3, fr = lane & 15, fq = lane >> 4;
    const int K = g.K, nt = K / BK;
    unsigned voffA[2], voffB[2];
#pragma unroll
    for (int i = 0; i < 2; ++i) { int R, C; stage_rc(tid * 16 + i * 8192, R, C); const int Rb = Epi::PERM ? ((R & ~31) + perm32(R & 31)) : R;
        voffA[i] = (unsigned)(R * K + C) * 2u; voffB[i] = (unsigned)(Rb * K + C) * 2u; }
    const size_t kstep = (size_t)(BK * 2);
    const size_t hstep = (size_t)HALF * K * 2;
    const size_t tstep = 2 * hstep;
    const unsigned ldsw = (unsigned)wid * 1024u;
    const int aoff = lds_byte(wr * 64 + fr, fq * 8), boff = lds_byte(wc * 32 + fr, fq * 8);
#define PG8_SA(b, h) (((b) * 2 + (h)) * HTB)
#define PG8_SB(b, h) ((4 + (b) * 2 + (h)) * HTB)
#define PG8_STAGE(bufoff, gbase, voff) do { _Pragma("unroll") for (int _i = 0; _i < 2; ++_i) \
        __builtin_amdgcn_global_load_lds((const unsigned*)((const char*)(gbase) + (voff)[_i]), (PG8_LAS unsigned*)(lds + (bufoff) + ldsw + _i * 8192), 16, 0, 0); } while (0)
#define PG8_LDA(dst, b, h) do { _Pragma("unroll") for (int m = 0; m < 4; ++m) _Pragma("unroll") for (int k = 0; k < 2; ++k) dst[m][k] = *(const PG8_LAS bf16x8*)(lds + PG8_SA(b, h) + aoff + m * 2048 + k * 1024); } while (0)
#define PG8_LDB(dst, b, h) do { _Pragma("unroll") for (int n = 0; n < 2; ++n) _Pragma("unroll") for (int k = 0; k < 2; ++k) dst[n][k] = *(const PG8_LAS bf16x8*)(lds + PG8_SB(b, h) + boff + n * 2048 + k * 1024); } while (0)
#define PG8_MMA(ai, bj, At, Bt) do { __builtin_amdgcn_s_setprio(1); _Pragma("unroll") for (int m = 0; m < 4; ++m) _Pragma("unroll") for (int n = 0; n < 2; ++n) { \
        if constexpr (FP8) { asm volatile("v_mfma_f32_16x16x128_f8f6f4 %0, %1, %2, %0" : "+v"(acc[ai][bj][m][n]) : "v"(cat8(Bt[n][0], Bt[n][1])), "v"(cat8(At[m][0], At[m][1]))); } \
        else { _Pragma("unroll") for (int k = 0; k < 2; ++k) acc[ai][bj][m][n] = __builtin_amdgcn_mfma_f32_16x16x32_bf16(Bt[n][k], At[m][k], acc[ai][bj][m][n], 0, 0, 0); } } __builtin_amdgcn_s_setprio(0); } while (0)
#define PG8_WAIT_V(n) asm volatile("s_waitcnt vmcnt(" #n ")" ::: "memory")
#define PG8_WAIT_L(n) asm volatile("s_waitcnt lgkmcnt(" #n ")" ::: "memory")
#define PG8_BAR __builtin_amdgcn_s_barrier()
#define PG8_SCHED __builtin_amdgcn_sched_barrier(0)
    Unit cur, nxt; int ui = 0;
    if (!S.next(0, cur)) return;
    f32x4 acc[2][2][4][2];
#pragma unroll
    for (int a = 0; a < 2; ++a)
#pragma unroll
        for (int b = 0; b < 2; ++b)
#pragma unroll
            for (int m = 0; m < 4; ++m)
#pragma unroll
                for (int n = 0; n < 2; ++n) acc[a][b][m][n] = (f32x4){0.f, 0.f, 0.f, 0.f};
    bf16x8 At[4][2], B0[2][2], B1[2][2];
    const char* cA = (const char*)g.A + (size_t)cur.pm * tstep; const char* cB = (const char*)g.Bt + (size_t)cur.pb * tstep;
    S.a_ready(cur);
    if constexpr (SP2) {
        PG8_STAGE(PG8_SB(0, 0), cB, voffB); PG8_STAGE(PG8_SB(0, 1), cB + hstep, voffB); PG8_STAGE(PG8_SA(0, 0), cA, voffA); PG8_STAGE(PG8_SA(0, 1), cA + hstep, voffA);
        if (wr == 1) PG8_BAR;
        PG8_WAIT_V(2); PG8_BAR;
        PG8_STAGE(PG8_SB(1, 0), cB + kstep, voffB); PG8_STAGE(PG8_SA(1, 0), cA + kstep, voffA); PG8_STAGE(PG8_SB(1, 1), cB + hstep + kstep, voffB);
        PG8_WAIT_V(6); PG8_BAR;
    } else {
        PG8_STAGE(PG8_SB(0, 0), cB, voffB); PG8_STAGE(PG8_SA(0, 0), cA, voffA); PG8_STAGE(PG8_SB(0, 1), cB + hstep, voffB); PG8_STAGE(PG8_SA(0, 1), cA + hstep, voffA);
        if (wr == 1) PG8_BAR;
        PG8_WAIT_V(4); PG8_BAR;
        PG8_STAGE(PG8_SB(1, 0), cB + kstep, voffB); PG8_STAGE(PG8_SA(1, 0), cA + kstep, voffA); PG8_STAGE(PG8_SB(1, 1), cB + hstep + kstep, voffB);
        PG8_WAIT_V(6); PG8_BAR;
    }
    for (;;) {
        const bool has_next = S.next(ui + 1, nxt);
        const char* nA = has_next ? (const char*)g.A + (size_t)nxt.pm * tstep : cA; const char* nB = has_next ? (const char*)g.Bt + (size_t)nxt.pb * tstep : cB;
        for (int t = 0; t < nt; t += 2) {
            const bool last = (t == nt - 2);
            const char* a1 = cA + (size_t)(t + 1) * kstep;
            const char* a2 = last ? nA : cA + (size_t)(t + 2) * kstep; const char* b2 = last ? nB : cB + (size_t)(t + 2) * kstep;
            const char* a3 = a2 + kstep; const char* b3 = b2 + kstep;
            if (last && has_next) S.a_ready(nxt);
            if constexpr (SP2) {
            PG8_LDB(B0, 0, 0); PG8_LDB(B1, 0, 1); PG8_SCHED; PG8_LDA(At, 0, 0); PG8_STAGE(PG8_SA(1, 1), a1 + hstep, voffA);
            PG8_WAIT_V(8); PG8_WAIT_L(0); PG8_BAR; PG8_MMA(0, 0, At, B0); PG8_MMA(0, 1, At, B1); PG8_BAR; PG8_SCHED;
            PG8_LDA(At, 0, 1); PG8_STAGE(PG8_SB(0, 0), b2, voffB); PG8_STAGE(PG8_SB(0, 1), b2 + hstep, voffB); PG8_STAGE(PG8_SA(0, 0), a2, voffA);
            PG8_WAIT_V(8); PG8_WAIT_L(0); PG8_BAR; PG8_MMA(1, 0, At, B0); PG8_MMA(1, 1, At, B1); PG8_BAR; PG8_SCHED;
            PG8_LDB(B0, 1, 0); PG8_LDB(B1, 1, 1); PG8_SCHED; PG8_LDA(At, 1, 0); PG8_STAGE(PG8_SA(0, 1), a2 + hstep, voffA);
            PG8_WAIT_V(8); PG8_WAIT_L(0); PG8_BAR; PG8_MMA(0, 0, At, B0); PG8_MMA(0, 1, At, B1); PG8_BAR; PG8_SCHED;
            PG8_LDA(At, 1, 1); PG8_STAGE(PG8_SB(1, 0), b3, voffB); PG8_STAGE(PG8_SB(1, 1), b3 + hstep, voffB); PG8_STAGE(PG8_SA(1, 0), a3, voffA);
            PG8_WAIT_V(8); PG8_WAIT_L(0); PG8_BAR; PG8_MMA(1, 0, At, B0); PG8_MMA(1, 1, At, B1); PG8_BAR; PG8_SCHED;
            } else {
            PG8_LDB(B0, 0, 0); PG8_SCHED; PG8_LDA(At, 0, 0); PG8_STAGE(PG8_SA(1, 1), a1 + hstep, voffA);
            PG8_WAIT_L(8); PG8_BAR; PG8_WAIT_L(0); PG8_MMA(0, 0, At, B0); PG8_BAR; PG8_SCHED;
            PG8_LDB(B1, 0, 1); PG8_STAGE(PG8_SB(0, 0), b2, voffB);
            PG8_BAR; PG8_WAIT_L(0); PG8_MMA(0, 1, At, B1); PG8_BAR;
            PG8_LDA(At, 0, 1); PG8_STAGE(PG8_SA(0, 0), a2, voffA);
            PG8_BAR; PG8_WAIT_L(0); PG8_MMA(1, 0, At, B0); PG8_BAR; PG8_SCHED;
            PG8_STAGE(PG8_SB(0, 1), b2 + hstep, voffB);
            PG8_WAIT_V(6); PG8_BAR; PG8_MMA(1, 1, At, B1); PG8_BAR;
            PG8_LDB(B0, 1, 0); PG8_SCHED; PG8_LDA(At, 1, 0); PG8_STAGE(PG8_SA(0, 1), a2 + hstep, voffA);
            PG8_WAIT_L(8); PG8_BAR; PG8_WAIT_L(0); PG8_MMA(0, 0, At, B0); PG8_BAR; PG8_SCHED;
            PG8_LDB(B1, 1, 1); PG8_STAGE(PG8_SB(1, 0), b3, voffB);
            PG8_BAR; PG8_WAIT_L(0); PG8_MMA(0, 1, At, B1); PG8_BAR;
            PG8_LDA(At, 1, 1); PG8_STAGE(PG8_SA(1, 0), a3, voffA);
            PG8_BAR; PG8_WAIT_L(0); PG8_MMA(1, 0, At, B0); PG8_BAR; PG8_SCHED;
            PG8_STAGE(PG8_SB(1, 1), b3 + hstep, voffB);
            PG8_WAIT_V(6); PG8_BAR; PG8_MMA(1, 1, At, B1); PG8_BAR;
            }
        }
        if constexpr (FP8) asm volatile("s_nop 15\n\ts_nop 15\n\ts_nop 15\n\ts_nop 15" ::: "memory");
        if constexpr (ALIGN_EPI) { if (wr == 0) PG8_BAR; }
        if constexpr (!Epi::AFTER_DRAIN) { E(acc, cur, wr, wc, fr, fq); S.done(cur); }
        if (!has_next) break;
#pragma unroll
        for (int a = 0; a < 2; ++a)
#pragma unroll
            for (int b = 0; b < 2; ++b)
#pragma unroll
                for (int m = 0; m < 4; ++m)
#pragma unroll
                    for (int n = 0; n < 2; ++n) acc[a][b][m][n] = (f32x4){0.f, 0.f, 0.f, 0.f};
        cur = nxt; cA = nA; cB = nB; ++ui;
        if constexpr (ALIGN_EPI) { if (wr == 1) PG8_BAR; }
    }
    PG8_WAIT_V(0);
    if constexpr (!ALIGN_EPI) { if (wr == 0) PG8_BAR; }
    PG8_BAR;
    if constexpr (Epi::AFTER_DRAIN) { E.fused(acc, cur, wr, wc, fr, fq, lds, wid, lane); S.done(cur); }
#undef PG8_SA
#undef PG8_SB
#undef PG8_STAGE
#undef PG8_LDA
#undef PG8_LDB
#undef PG8_MMA
#undef PG8_WAIT_V
#undef PG8_WAIT_L
#undef PG8_BAR
#undef PG8_SCHED
}
}

#define PG8_SP2 true
#define PG8_ALIGN true

constexpr size_t WS_WIN_T = 1056 * MiB;
constexpr size_t WS_WOUT_T = 1102 * MiB;
constexpr size_t WS_FGU_T = 1118 * MiB;
constexpr size_t WS_FD_T = 1162 * MiB;
constexpr size_t WS_MGU_T = 1184 * MiB;
constexpr size_t WS_MD_T = 1632 * MiB;
constexpr size_t WS_END2 = 1856 * MiB;
constexpr size_t WS_HB = WS_HPERM;
static_assert(WS_WIN_T + (size_t)2 * PW * D * 2 <= WS_WOUT_T && WS_WOUT_T + (size_t)2 * D * D * 2 <= WS_FGU_T && WS_FGU_T + (size_t)2 * DFF * D * 2 <= WS_FD_T && WS_FD_T + (size_t)DFF * D * 2 <= WS_MGU_T
              && WS_MGU_T + (size_t)NE * 2 * DFE * D * 2 <= WS_MD_T && WS_MD_T + (size_t)NE * DFE * D * 2 <= WS_END2, "weight map");

struct EpiStoreBf16 {
    static constexpr bool PERM = true, AFTER_DRAIN = false;
    bf16* O; int ldc;
    __device__ __forceinline__ void operator()(const f32x4 (&acc)[2][2][4][2], const pg8::Unit& u, int wr, int wc, int fr, int fq) const {
        const int row0 = u.pm * 256 + wr * 64 + fr, col0 = u.pn * 256 + wc * 32 + 8 * fq;
#pragma unroll
        for (int ai = 0; ai < 2; ++ai)
#pragma unroll
            for (int m = 0; m < 4; ++m) { bf16* rowp = O + (size_t)(row0 + ai * 128 + m * 16) * ldc + col0;
#pragma unroll
                for (int bj = 0; bj < 2; ++bj) { const f32x4 v0 = acc[ai][bj][m][0], v1 = acc[ai][bj][m][1]; u32x4 w; w.x = pg8::cvt_pk_bf16(v0[0], v0[1]); w.y = pg8::cvt_pk_bf16(v0[2], v0[3]); w.z = pg8::cvt_pk_bf16(v1[0], v1[1]); w.w = pg8::cvt_pk_bf16(v1[2], v1[3]);
                    *(u32x4*)(rowp + bj * 128) = w; } }
    }
};
struct EpiSwiglu {
    static constexpr bool PERM = true, AFTER_DRAIN = false;
    bf16* O; int ldc; float asc;
    __device__ __forceinline__ void operator()(const f32x4 (&acc)[2][2][4][2], const pg8::Unit& u, int wr, int wc, int fr, int fq) const {
        const int row0 = u.pm * 256 + wr * 64 + fr, col0 = u.pn * 128 + wc * 32 + 8 * fq;
#pragma unroll
        for (int ai = 0; ai < 2; ++ai)
#pragma unroll
            for (int m = 0; m < 4; ++m) { bf16* rowp = O + (size_t)(row0 + ai * 128 + m * 16) * ldc + col0;
                float o[8];
#pragma unroll
                for (int n = 0; n < 2; ++n)
#pragma unroll
                    for (int i = 0; i < 4; ++i) { const float g = acc[ai][0][m][n][i] * asc, up = acc[ai][1][m][n][i] * asc; o[n * 4 + i] = g * __builtin_amdgcn_rcpf(1.f + __expf(-g)) * up; }
                u32x4 w; w.x = pg8::cvt_pk_bf16(o[0], o[1]); w.y = pg8::cvt_pk_bf16(o[2], o[3]); w.z = pg8::cvt_pk_bf16(o[4], o[5]); w.w = pg8::cvt_pk_bf16(o[6], o[7]);
                *(u32x4*)rowp = w; }
    }
};
struct EpiResid {
    static constexpr bool PERM = false, AFTER_DRAIN = false;
    const float* xin; float* out; const float* gmod; float asc;
    __device__ __forceinline__ void operator()(const f32x4 (&acc)[2][2][4][2], const pg8::Unit& u, int wr, int wc, int fr, int fq) const {
        const int row0 = u.pm * 256 + wr * 64 + fr, col0 = u.pn * 256 + wc * 32 + 4 * fq;
        const float* gm = gmod + (size_t)((u.pm * 256) >> 12) * D6 + col0;
        f32x4 gv[2][2];
#pragma unroll
        for (int bj = 0; bj < 2; ++bj)
#pragma unroll
            for (int n = 0; n < 2; ++n) gv[bj][n] = (1.f + *(const f32x4*)(gm + bj * 128 + n * 16)) * asc;
#pragma unroll
        for (int ai = 0; ai < 2; ++ai) {
            f32x4 xv[4][2][2];
#pragma unroll
            for (int m = 0; m < 4; ++m) { const size_t off = (size_t)(row0 + ai * 128 + m * 16) * D + col0;
#pragma unroll
                for (int bj = 0; bj < 2; ++bj)
#pragma unroll
                    for (int n = 0; n < 2; ++n) xv[m][bj][n] = *(const f32x4*)(xin + off + bj * 128 + n * 16); }
            __builtin_amdgcn_sched_barrier(0);
#pragma unroll
            for (int m = 0; m < 4; ++m) { const size_t off = (size_t)(row0 + ai * 128 + m * 16) * D + col0;
#pragma unroll
                for (int bj = 0; bj < 2; ++bj)
#pragma unroll
                    for (int n = 0; n < 2; ++n) *(f32x4*)(out + off + bj * 128 + n * 16) = ALPHA * xv[m][bj][n] + gv[bj][n] * acc[ai][bj][m][n]; }
            __builtin_amdgcn_sched_barrier(0);
        }
    }
};
template <bool XF32> struct EpiResidB {
    static constexpr bool PERM = true, AFTER_DRAIN = false;
    const void* xin; bf16* out; const float* gmod; float asc;
    __device__ __forceinline__ void operator()(const f32x4 (&acc)[2][2][4][2], const pg8::Unit& u, int wr, int wc, int fr, int fq) const {
        const int row0 = u.pm * 256 + wr * 64 + fr, col0 = u.pn * 256 + wc * 32 + 8 * fq;
        const float* gm = gmod + (size_t)((u.pm * 256) >> 12) * D6 + col0;
        f32x4 gv[2][2];
#pragma unroll
        for (int bj = 0; bj < 2; ++bj)
#pragma unroll
            for (int n = 0; n < 2; ++n) gv[bj][n] = (1.f + *(const f32x4*)(gm + bj * 128 + n * 4)) * asc;
#pragma unroll
        for (int ai = 0; ai < 2; ++ai) {
            f32x4 xv[4][2][2]; u32x4 xb[4][2];
#pragma unroll
            for (int m = 0; m < 4; ++m) { const size_t off = (size_t)(row0 + ai * 128 + m * 16) * D + col0;
#pragma unroll
                for (int bj = 0; bj < 2; ++bj) {
                    if (XF32) {
#pragma unroll
                        for (int n = 0; n < 2; ++n) xv[m][bj][n] = *(const f32x4*)((const float*)xin + off + bj * 128 + n * 4); }
                    else xb[m][bj] = *(const u32x4*)((const bf16*)xin + off + bj * 128); } }
            __builtin_amdgcn_sched_barrier(0);
#pragma unroll
            for (int m = 0; m < 4; ++m) { const size_t off = (size_t)(row0 + ai * 128 + m * 16) * D + col0;
#pragma unroll
                for (int bj = 0; bj < 2; ++bj) {
                    f32x4 x0, x1;
                    if (XF32) { x0 = xv[m][bj][0]; x1 = xv[m][bj][1]; }
                    else { const u32x4 w = xb[m][bj]; x0 = (f32x4){bflo(w.x), bfhi(w.x), bflo(w.y), bfhi(w.y)}; x1 = (f32x4){bflo(w.z), bfhi(w.z), bflo(w.w), bfhi(w.w)}; }
                    const f32x4 o0 = ALPHA * x0 + gv[bj][0] * acc[ai][bj][m][0], o1 = ALPHA * x1 + gv[bj][1] * acc[ai][bj][m][1];
                    u32x4 pw; pw.x = pk2(o0.x, o0.y); pw.y = pk2(o0.z, o0.w); pw.z = pk2(o1.x, o1.y); pw.w = pk2(o1.z, o1.w);
                    *(u32x4*)(out + off + bj * 128) = pw; } }
            __builtin_amdgcn_sched_barrier(0);
        }
    }
};
struct EpiF32 {
    static constexpr bool PERM = false, AFTER_DRAIN = false;
    float* O; int ldc;
    __device__ __forceinline__ void operator()(const f32x4 (&acc)[2][2][4][2], const pg8::Unit& u, int wr, int wc, int fr, int fq) const {
        const int row0 = u.pm * 256 + wr * 64 + fr, col0 = u.pn * 256 + wc * 32 + 4 * fq;
#pragma unroll
        for (int ai = 0; ai < 2; ++ai)
#pragma unroll
            for (int m = 0; m < 4; ++m) { const size_t off = (size_t)(row0 + ai * 128 + m * 16) * ldc + col0;
#pragma unroll
                for (int bj = 0; bj < 2; ++bj)
#pragma unroll
                    for (int n = 0; n < 2; ++n) *(f32x4*)(O + off + bj * 128 + n * 16) = acc[ai][bj][m][n]; }
    }
};

#ifndef MOE_FP8
#define MOE_FP8 1
#endif
#ifndef FFN_FP8
#define FFN_FP8 2
#endif
#define FFN8_GU ((FFN_FP8 & 1) != 0)
#define FFN8_DN ((FFN_FP8 & 2) != 0)
constexpr float F8_FD = 128.f;
constexpr float F8_WGU = 32.f, F8_WD = 128.f;
__device__ __forceinline__ unsigned pk4_fp8(float a, float b, float c, float d) { int p = __builtin_amdgcn_cvt_pk_fp8_f32(a, b, 0, false); p = __builtin_amdgcn_cvt_pk_fp8_f32(c, d, p, true); return (unsigned)p; }
struct EpiSwiglu8 {
    static constexpr bool PERM = true, AFTER_DRAIN = false;
    unsigned char* O; int ldc; float asc;
    __device__ __forceinline__ void operator()(const f32x4 (&acc)[2][2][4][2], const pg8::Unit& u, int wr, int wc, int fr, int fq) const {
        const int row0 = u.pm * 256 + wr * 64 + fr, col0 = u.pn * 128 + wc * 32 + 8 * fq;
#pragma unroll
        for (int ai = 0; ai < 2; ++ai)
#pragma unroll
            for (int m = 0; m < 4; ++m) { unsigned char* rowp = O + (size_t)(row0 + ai * 128 + m * 16) * ldc + col0;
                float o[8];
#pragma unroll
                for (int n = 0; n < 2; ++n)
#pragma unroll
                    for (int i = 0; i < 4; ++i) { const float g = acc[ai][0][m][n][i] * asc, up = acc[ai][1][m][n][i] * asc; o[n * 4 + i] = g * __builtin_amdgcn_rcpf(1.f + __expf(-g)) * up; }
                u32x2 w; w.x = pk4_fp8(o[0], o[1], o[2], o[3]); w.y = pk4_fp8(o[4], o[5], o[6], o[7]);
                *(u32x2*)rowp = w; }
    }
};
struct EpiBf16S {
    static constexpr bool PERM = false, AFTER_DRAIN = false;
    bf16* O; int ldc; float s;
    __device__ __forceinline__ void operator()(const f32x4 (&acc)[2][2][4][2], const pg8::Unit& u, int wr, int wc, int fr, int fq) const {
        const int row0 = u.pm * 256 + wr * 64 + fr, col0 = u.pn * 256 + wc * 32 + 4 * fq;
#pragma unroll
        for (int ai = 0; ai < 2; ++ai)
#pragma unroll
            for (int m = 0; m < 4; ++m) { const size_t off = (size_t)(row0 + ai * 128 + m * 16) * ldc + col0;
#pragma unroll
                for (int bj = 0; bj < 2; ++bj)
#pragma unroll
                    for (int n = 0; n < 2; ++n) { const f32x4 v = acc[ai][bj][m][n] * s; u32x2 w; w.x = pg8::cvt_pk_bf16(v[0], v[1]); w.y = pg8::cvt_pk_bf16(v[2], v[3]); *(u32x2*)(O + off + bj * 128 + n * 16) = w; } }
    }
};
struct EpiF32S {
    static constexpr bool PERM = false, AFTER_DRAIN = false;
    float* O; int ldc; float s;
    __device__ __forceinline__ void operator()(const f32x4 (&acc)[2][2][4][2], const pg8::Unit& u, int wr, int wc, int fr, int fq) const {
        const int row0 = u.pm * 256 + wr * 64 + fr, col0 = u.pn * 256 + wc * 32 + 4 * fq;
#pragma unroll
        for (int ai = 0; ai < 2; ++ai)
#pragma unroll
            for (int m = 0; m < 4; ++m) { const size_t off = (size_t)(row0 + ai * 128 + m * 16) * ldc + col0;
#pragma unroll
                for (int bj = 0; bj < 2; ++bj)
#pragma unroll
                    for (int n = 0; n < 2; ++n) *(f32x4*)(O + off + bj * 128 + n * 16) = acc[ai][bj][m][n] * s; }
    }
};
template <class RM> __device__ __forceinline__ void transpose_item_f8(const float* W, int K, int N, unsigned char* WT, int item, int lane, const RM& rm, float scale) {
    const int nblk = (N + 63) >> 6, kb = item / nblk, nb = item - kb * nblk, k0 = 64 * kb + 16 * (lane >> 4), n = 64 * nb + 4 * (lane & 15);
    if (n >= N) return;
    const float* src = W + (size_t)k0 * N + n;
    f32x4 v[16];
#pragma unroll
    for (int i = 0; i < 16; ++i) v[i] = *(const f32x4*)(src + (size_t)i * N) * scale;
#pragma unroll
    for (int j = 0; j < 4; ++j) { u32x4 o;
        o.x = pk4_fp8(v[0][j], v[1][j], v[2][j], v[3][j]); o.y = pk4_fp8(v[4][j], v[5][j], v[6][j], v[7][j]); o.z = pk4_fp8(v[8][j], v[9][j], v[10][j], v[11][j]); o.w = pk4_fp8(v[12][j], v[13][j], v[14][j], v[15][j]);
        *(u32x4*)(WT + (size_t)rm(n + j) * K + k0) = o; }
}
struct MoeOrder {
    int nP, nN, nU, G, c; int b1, b2, b3, b4, b5, b6, b7;
    __device__ __forceinline__ void init(const int* moe_base, int N, int G_, int c_) { nP = __builtin_amdgcn_readfirstlane(moe_base[8]) >> 8; nN = N / 256; nU = nP * nN; G = G_; c = c_;
        b1 = __builtin_amdgcn_readfirstlane(moe_base[1]); b2 = __builtin_amdgcn_readfirstlane(moe_base[2]); b3 = __builtin_amdgcn_readfirstlane(moe_base[3]); b4 = __builtin_amdgcn_readfirstlane(moe_base[4]);
        b5 = __builtin_amdgcn_readfirstlane(moe_base[5]); b6 = __builtin_amdgcn_readfirstlane(moe_base[6]); b7 = __builtin_amdgcn_readfirstlane(moe_base[7]); }
    __device__ __forceinline__ bool next(int i, pg8::Unit& u) const {
        const int L = i * G + c; if (L >= nU) return false;
        const int nig = 8 * nN, gid = L / nig, fm = gid * 8, gsz = (nP - fm) < 8 ? (nP - fm) : 8, r = L % nig;
        u.pm = fm + r % gsz; u.pn = r / gsz;
        const int row0 = u.pm * 256; const int e = (row0 >= b1) + (row0 >= b2) + (row0 >= b3) + (row0 >= b4) + (row0 >= b5) + (row0 >= b6) + (row0 >= b7);
        u.pb = e * nN + u.pn; return true;
    }
    __device__ __forceinline__ void a_ready(const pg8::Unit&) const {}
    __device__ __forceinline__ void done(const pg8::Unit&) const {}
};

template <class RM> __device__ __forceinline__ void transpose_item(const float* W, int K, int N, bf16* WT, LAS float*, int item, int lane, const RM& rm, int pitch = 0) {
    if (pitch == 0) pitch = K;
    const int nblk = (N + 63) >> 6, kb = item / nblk, nb = item - kb * nblk, k0 = 64 * kb + 16 * (lane >> 4), n = 64 * nb + 4 * (lane & 15);
    if (n >= N) return;
    const float* src = W + (size_t)k0 * N + n;
    f32x4 v[16];
#pragma unroll
    for (int i = 0; i < 16; ++i) v[i] = *(const f32x4*)(src + (size_t)i * N);
#pragma unroll
    for (int j = 0; j < 4; ++j) { bf16* dst = WT + (size_t)rm(n + j) * pitch + k0;
        u32x4 o0, o1;
        o0.x = pk2(v[0][j], v[1][j]); o0.y = pk2(v[2][j], v[3][j]); o0.z = pk2(v[4][j], v[5][j]); o0.w = pk2(v[6][j], v[7][j]);
        o1.x = pk2(v[8][j], v[9][j]); o1.y = pk2(v[10][j], v[11][j]); o1.z = pk2(v[12][j], v[13][j]); o1.w = pk2(v[14][j], v[15][j]);
        *(u32x4*)dst = o0; *(u32x4*)(dst + 8) = o1; }
}
__device__ __forceinline__ int inproj_dst_row(int s) {
    if (s < 2560) return s;
    if (s < 2584) return s + 3072;
    if (s < 4632) return s - 24;
    if (s < 4648) return s + 1024;
    return s - 40;
}
struct WItem { const float* src; unsigned char* dst; int N, K, k0, n, kind; bool f8, valid; float scale; };
__device__ __forceinline__ int witem_row(int kind, int n) {
    if (kind == 1) return inproj_dst_row(n);
    if (kind == 2) return ((n >> 7) << 8) + (n & 127);
    if (kind == 3) return ((n >> 7) << 8) + 128 + (n & 127);
    return n;
}
__device__ __forceinline__ void witem_load(const WItem& w, f32x4 (&v)[16]) {
    if (!w.valid) return;
#pragma unroll
    for (int i = 0; i < 16; ++i) v[i] = *(const f32x4*)(w.src + (size_t)i * w.N);
}
__device__ __forceinline__ void witem_store(const WItem& w, const f32x4 (&v)[16]) {
    if (!w.valid) return;
    if (w.f8) {
#pragma unroll
        for (int j = 0; j < 4; ++j) { u32x4 o; const float sc = w.scale;
            o.x = pk4_fp8(v[0][j] * sc, v[1][j] * sc, v[2][j] * sc, v[3][j] * sc); o.y = pk4_fp8(v[4][j] * sc, v[5][j] * sc, v[6][j] * sc, v[7][j] * sc);
            o.z = pk4_fp8(v[8][j] * sc, v[9][j] * sc, v[10][j] * sc, v[11][j] * sc); o.w = pk4_fp8(v[12][j] * sc, v[13][j] * sc, v[14][j] * sc, v[15][j] * sc);
            *(u32x4*)(w.dst + (size_t)witem_row(w.kind, w.n + j) * w.K + w.k0) = o; }
    } else {
#pragma unroll
        for (int j = 0; j < 4; ++j) { bf16* dst = (bf16*)w.dst + (size_t)witem_row(w.kind, w.n + j) * w.K + w.k0;
            u32x4 o0, o1;
            o0.x = pk2(v[0][j], v[1][j]); o0.y = pk2(v[2][j], v[3][j]); o0.z = pk2(v[4][j], v[5][j]); o0.w = pk2(v[6][j], v[7][j]);
            o1.x = pk2(v[8][j], v[9][j]); o1.y = pk2(v[10][j], v[11][j]); o1.z = pk2(v[12][j], v[13][j]); o1.w = pk2(v[14][j], v[15][j]);
            *(u32x4*)dst = o0; *(u32x4*)(dst + 8) = o1; }
    }
}
__device__ __forceinline__ void p0_weights(const Args& a, LAS unsigned char* lds) {
    const int lane = threadIdx.x & 63, wave = __builtin_amdgcn_readfirstlane(threadIdx.x >> 6);
    const int gw = blockIdx.x * 8 + wave, NGW = gridDim.x * 8;
    constexpr int I_IN = 16 * 178, I_OUT = 16 * 64, I_FG = 16 * 176, I_FD = 44 * 64, I_MG = 16 * 224, I_MD = 56 * 64;
    constexpr int NIT = 2 * I_IN + 2 * I_OUT + 2 * I_FG + I_FD + 16 * I_MG + 8 * I_MD;
    auto decode = [&](int it) -> WItem {
        WItem w; w.valid = false; w.src = nullptr; w.dst = nullptr; w.N = 0; w.K = 0; w.k0 = 0; w.n = 0; w.kind = 0; w.f8 = false; w.scale = 1.f;
        if (it >= NIT) return w;
        int r = it; const float* W;
        if (r < 2 * I_IN) { const int l = r / I_IN; r -= l * I_IN; W = a.in[I_WIN] + (size_t)l * D * INW; w.K = D; w.N = INW; w.dst = a.ws + WS_WIN_T + (size_t)l * PW * D * 2; w.kind = 1; }
        else if ((r -= 2 * I_IN) < 2 * I_OUT) { const int l = r / I_OUT; r -= l * I_OUT; W = a.in[I_WOUT] + (size_t)l * D * D; w.K = D; w.N = D; w.dst = a.ws + WS_WOUT_T + (size_t)l * D * D * 2; }
        else if ((r -= 2 * I_OUT) < 2 * I_FG) { const int up = r / I_FG; r -= up * I_FG; W = a.in[up ? I_FWU : I_FWG]; w.K = D; w.N = DFF; w.dst = a.ws + WS_FGU_T; w.kind = 2 + up; w.f8 = FFN8_GU; w.scale = F8_WGU; }
        else if ((r -= 2 * I_FG) < I_FD) { W = a.in[I_FWD]; w.K = DFF; w.N = D; w.dst = a.ws + WS_FD_T; w.f8 = FFN8_DN; w.scale = F8_FD; }
        else if ((r -= I_FD) < 16 * I_MG) { const int up = r / (8 * I_MG); r -= up * 8 * I_MG; const int e = r / I_MG; r -= e * I_MG; W = a.in[up ? I_MWU : I_MWG] + (size_t)e * D * DFE; w.K = D; w.N = DFE;
            w.dst = a.ws + WS_MGU_T + (size_t)e * 2 * DFE * D * (MOE_FP8 ? 1 : 2); w.kind = 2 + up; w.f8 = MOE_FP8; w.scale = F8_WGU; }
        else { r -= 16 * I_MG; const int e = r / I_MD; r -= e * I_MD; W = a.in[I_MWD] + (size_t)e * DFE * D; w.K = DFE; w.N = D; w.dst = a.ws + WS_MD_T + (size_t)e * D * DFE * (MOE_FP8 ? 1 : 2); w.f8 = MOE_FP8; w.scale = F8_WD; }
        const int nblk = (w.N + 31) >> 5, kb = r / nblk, nb = r - kb * nblk;
        w.k0 = 128 * kb + 16 * (lane >> 3); w.n = 32 * nb + 4 * (lane & 7); w.valid = w.n < w.N; w.src = W + (size_t)w.k0 * w.N + w.n;
        return w;
    };
    { f32x4 v[16], vn[16];
      WItem cur = decode(gw); witem_load(cur, v);
#pragma unroll 1
      for (int it = gw; it < NIT; it += NGW) {
          const WItem nxt = decode(it + NGW); witem_load(nxt, vn);
          __builtin_amdgcn_sched_barrier(0);
          witem_store(cur, v);
          __builtin_amdgcn_sched_barrier(0);
#pragma unroll
          for (int i = 0; i < 16; ++i) v[i] = vn[i];
          cur = nxt; } }
    for (int idx = blockIdx.x * 512 + threadIdx.x; idx < 2 * (PW - INW) * D / 8; idx += gridDim.x * 512) {
        const int l = idx / ((PW - INW) * D / 8), r = idx - l * ((PW - INW) * D / 8);
        *(u32x4*)((bf16*)(a.ws + WS_WIN_T) + (size_t)l * PW * D + (size_t)INW * D + (size_t)r * 8) = (u32x4){0u, 0u, 0u, 0u};
    }
}
__device__ __forceinline__ void p_mod_rows(const Args& a, const float* X, const float* modsh, const float* modsc) {
    const int lane = threadIdx.x & 63, wave = __builtin_amdgcn_readfirstlane(threadIdx.x >> 6);
    bf16* HB = (bf16*)(a.ws + WS_HB);
    const int gw = blockIdx.x * 8 + wave, NGW = gridDim.x * 8;
    f32x4 v[8], vn[8];
    if (gw < M) {
#pragma unroll
        for (int j = 0; j < 8; ++j) v[j] = *(const f32x4*)(X + (size_t)gw * D + j * 256 + lane * 4); }
#pragma unroll 1
    for (int m = gw; m < M; m += NGW) { const size_t bo = (size_t)(m >> 12) * D6; const int mn = m + NGW;
        if (mn < M) {
#pragma unroll
            for (int j = 0; j < 8; ++j) vn[j] = *(const f32x4*)(X + (size_t)mn * D + j * 256 + lane * 4); }
        f32x4 shv[8], scv[8];
#pragma unroll
        for (int j = 0; j < 8; ++j) { const int k = j * 256 + lane * 4; shv[j] = *(const f32x4*)(modsh + bo + k); scv[j] = *(const f32x4*)(modsc + bo + k); }
        __builtin_amdgcn_sched_barrier(0);
#pragma unroll
        for (int j = 0; j < 8; ++j) st_bf4(HB + (size_t)m * D + j * 256 + lane * 4, v[j] * (1.f + scv[j]) + shv[j]);
        __builtin_amdgcn_sched_barrier(0);
#pragma unroll
        for (int j = 0; j < 8; ++j) v[j] = vn[j]; }
}

template <bool DUAL, class AL, class BL, class EP>
__device__ __forceinline__ void ggemm_tile(LAS float* lds, int m0, int n0, int K, const AL& al, const BL& bl, const EP& ep) {
    LAS float* As = lds; LAS float* Bs = lds + 16 * 132; LAS float* Bs2 = Bs + 16 * 128;
    const int tid = threadIdx.x, ty = tid >> 5, tx = tid & 31;
    const int ar = tid >> 2, ak = (tid & 3) * 4, bk = tid >> 5, bn = (tid & 31) * 4;
    f32x4 acc[8], acc2[8];
#pragma unroll
    for (int i = 0; i < 8; ++i) { acc[i] = (f32x4){0.f, 0.f, 0.f, 0.f}; acc2[i] = (f32x4){0.f, 0.f, 0.f, 0.f}; }
    f32x4 a = al(m0 + ar, ak), b = bl(bk, n0 + bn, 0), b2 = (f32x4){0.f, 0.f, 0.f, 0.f};
    if (DUAL) b2 = bl(bk, n0 + bn, 1);
    for (int k0 = 0; k0 < K; k0 += 16) {
        __syncthreads();
        As[(ak + 0) * 132 + ar] = a.x; As[(ak + 1) * 132 + ar] = a.y; As[(ak + 2) * 132 + ar] = a.z; As[(ak + 3) * 132 + ar] = a.w;
        *(LAS f32x4*)(Bs + bk * 128 + bn) = b;
        if (DUAL) *(LAS f32x4*)(Bs2 + bk * 128 + bn) = b2;
        __syncthreads();
        if (k0 + 16 < K) { a = al(m0 + ar, k0 + 16 + ak); b = bl(k0 + 16 + bk, n0 + bn, 0); if (DUAL) b2 = bl(k0 + 16 + bk, n0 + bn, 1); }
#pragma unroll
        for (int kk = 0; kk < 16; ++kk) {
            const f32x4 a0 = *(const LAS f32x4*)(As + kk * 132 + ty * 8), a1 = *(const LAS f32x4*)(As + kk * 132 + ty * 8 + 4);
            const f32x4 bv = *(const LAS f32x4*)(Bs + kk * 128 + tx * 4);
            acc[0] += a0.x * bv; acc[1] += a0.y * bv; acc[2] += a0.z * bv; acc[3] += a0.w * bv;
            acc[4] += a1.x * bv; acc[5] += a1.y * bv; acc[6] += a1.z * bv; acc[7] += a1.w * bv;
            if (DUAL) {
                const f32x4 bw = *(const LAS f32x4*)(Bs2 + kk * 128 + tx * 4);
                acc2[0] += a0.x * bw; acc2[1] += a0.y * bw; acc2[2] += a0.z * bw; acc2[3] += a0.w * bw;
                acc2[4] += a1.x * bw; acc2[5] += a1.y * bw; acc2[6] += a1.z * bw; acc2[7] += a1.w * bw;
            }
        }
    }
#pragma unroll
    for (int i = 0; i < 8; ++i) ep(m0 + ty * 8 + i, n0 + tx * 4, acc[i], acc2[i]);
}


__device__ __forceinline__ int vperm16(int k) { return (k & 3) + ((k & 8) >> 1) + ((k & 4) << 1); }
__device__ __forceinline__ int inproj_src_col(int n) {
    if (n < 2560) return n;
    if (n < 4608) return n + 24;
    if (n < 5632) return n + 40;
    if (n < 5656) return n - 3072;
    if (n < 5672) return n - 1024;
    return -1;
}

__device__ __forceinline__ void p0_mod(const Args& a, LAS unsigned char* lds) {
    LAS float* scl = (LAS float*)lds;
    LAS float* red = scl + 4 * 2048;
    const int tid = threadIdx.x;
    const float* c = a.in[I_C];
    for (int i = tid; i < 4 * 2048; i += 512) scl[i] = siluf_(c[i]);
    __syncthreads();
    float* mod = (float*)(a.ws + WS_MOD);
    const int cq = tid & 31, ks = tid >> 5;
    for (int item = blockIdx.x; item < 192; item += gridDim.x) {
        const int l = item / 96, col0 = (item % 96) * 128;
        const float* w = a.in[I_WADA] + (size_t)l * D * D6 + col0 + cq * 4;
        f32x4 acc[4];
#pragma unroll
        for (int b = 0; b < 4; ++b) acc[b] = (f32x4){0.f, 0.f, 0.f, 0.f};
#pragma unroll 1
        for (int k0 = 0; k0 < 128; k0 += 32) {
            f32x4 wv[32];
#pragma unroll
            for (int kk = 0; kk < 32; ++kk) wv[kk] = *(const f32x4*)(w + (size_t)(ks * 128 + k0 + kk) * D6);
            __builtin_amdgcn_sched_barrier(0);
#pragma unroll
            for (int kk = 0; kk < 32; ++kk) { const int k = ks * 128 + k0 + kk;
#pragma unroll
                for (int b = 0; b < 4; ++b) acc[b] += scl[b * 2048 + k] * wv[kk]; }
            __builtin_amdgcn_sched_barrier(0);
        }
        __syncthreads();
#pragma unroll
        for (int b = 0; b < 4; ++b) *(LAS f32x4*)(red + ks * 512 + b * 128 + cq * 4) = acc[b];
        __syncthreads();
        { const int b = tid >> 7, cc = tid & 127; float s = 0.f;
#pragma unroll
          for (int k2 = 0; k2 < 16; ++k2) s += red[k2 * 512 + tid];
          mod[(size_t)(l * 4 + b) * D6 + col0 + cc] = s + a.in[I_BADA][(size_t)l * D6 + col0 + cc]; }
    }
    const double INVREV[16] = {0.15915494309189535, 0.0700865215877985, 0.03086376340470123, 0.013591370636193905, 0.005985185712713705, 0.002635675898667414, 0.001160663641240061, 0.0005111175045375439,
                               0.00022507907903927653, 9.911730936901935e-05, 4.364795279280289e-05, 1.9221100684944863e-05, 8.464330808241401e-06, 3.727408601915352e-06, 1.6414262627950345e-06, 7.228293068832865e-07};
    float* rope = (float*)(a.ws + WS_ROPE);
    for (int idx = blockIdx.x * 512 + tid; idx < 4096 * 16; idx += gridDim.x * 512) {
        const int t = idx >> 4, i = idx & 15;
        double inv = INVREV[0];
#pragma unroll
        for (int j = 1; j < 16; ++j) inv = (i == j) ? INVREV[j] : inv;
        const double rev = (double)t * inv; const float fr = (float)(rev - __builtin_floor(rev));
        rope[t * 32 + i] = __builtin_amdgcn_cosf(fr); rope[t * 32 + 16 + i] = __builtin_amdgcn_sinf(fr);
    }
}

template <int L> __device__ __forceinline__ void p_inproj_g(const Args& a, LAS unsigned char* lds, const float* xin) {
    const float* mod = (const float*)(a.ws + WS_MOD) + (size_t)L * 4 * D6;
    const float* W = a.in[I_WIN] + (size_t)L * D * INW;
    bf16* proj = (bf16*)(a.ws + WS_PROJ);
    auto al = [&](int m, int k) -> f32x4 { const float* md = mod + (size_t)(m >> 12) * D6; const f32x4 x = *(const f32x4*)(xin + (size_t)m * D + k);
        const f32x4 sh = *(const f32x4*)(md + k), sc = *(const f32x4*)(md + 2048 + k); return x * (1.f + sc) + sh; };
    auto bl = [&](int k, int n, int) -> f32x4 { const int s = inproj_src_col(n); if (s < 0) return (f32x4){0.f, 0.f, 0.f, 0.f}; return *(const f32x4*)(W + (size_t)k * INW + s); };
    auto ep = [&](int m, int n, f32x4 v, f32x4) { st_bf4(proj + (size_t)m * PW + n, v); };
    for (int t = blockIdx.x; t < (M / 128) * (PW / 128); t += gridDim.x) { const int tm = t / (PW / 128), tn = t % (PW / 128);
        ggemm_tile<false>((LAS float*)lds, tm * 128, tn * 128, D, al, bl, ep); }
}

template <int L> __device__ __forceinline__ void p_cmp1_g(const Args& a, LAS unsigned char* lds) {
    bf16* proj = (bf16*)(a.ws + WS_PROJ);
    float* chid = (float*)(a.ws + WS_CHID);
    for (int t = blockIdx.x; t < 2 * 16 * 2; t += gridDim.x) {
        const int kind = t >> 5, tm = (t >> 1) & 15, tn = t & 1;
        const float* pe = a.in[kind ? I_CPV : I_CPK] + (size_t)L * 32 * 128;
        const float* W1 = a.in[kind ? I_CW1V : I_CW1K] + (size_t)L * 4096 * 256;
        const int coff = kind ? PVC : PKC;
        auto al = [&](int r, int k) -> f32x4 { const int c = r & 255, bh = r >> 8, b = bh >> 1, h = bh & 1; if (c >= 255) return (f32x4){0.f, 0.f, 0.f, 0.f};
            const int l = k >> 7, d = k & 127; const f32x4 v = ld_bf4(proj + (size_t)(b * T + 16 * c + l) * PW + coff + h * 128 + d); return v + *(const f32x4*)(pe + l * 128 + d); };
        auto bl = [&](int k, int n, int) -> f32x4 { return *(const f32x4*)(W1 + (size_t)k * 256 + n); };
        auto ep = [&](int r, int n, f32x4 v, f32x4) { f32x4 o; o.x = gelu_tanh(v.x); o.y = gelu_tanh(v.y); o.z = gelu_tanh(v.z); o.w = gelu_tanh(v.w); *(f32x4*)(chid + ((size_t)kind * NCR + r) * 256 + n) = o; };
        ggemm_tile<false>((LAS float*)lds, tm * 128, tn * 128, 4096, al, bl, ep);
    }
    const float* rope = (const float*)(a.ws + WS_ROPE);
    const int gt = blockIdx.x * 512 + threadIdx.x, NGT = gridDim.x * 512;
    for (int idx = gt; idx < M * 64; idx += NGT) {
        const int i = idx & 15, hh = (idx >> 4) & 1, ts = (idx >> 5) & 1, m = idx >> 6, t = m & (T - 1);
        bf16* p = proj + (size_t)m * PW + (ts ? PKW : PKS) + hh * 128 + i;
        const float x1 = bf1(p[0]), x2 = bf1(p[16]), c = rope[t * 32 + i], s = rope[t * 32 + 16 + i];
        p[0] = (bf16)f2bf(x1 * c - x2 * s); p[16] = (bf16)f2bf(x2 * c + x1 * s);
    }
    float* LA = (float*)(a.ws + WS_LA);
    const float* wa2 = a.in[I_GWA2] + (size_t)L * 16 * 512; const float* ba = a.in[I_GBA] + (size_t)L * 512;
    for (int idx = gt; idx < M * 512; idx += NGT) {
        const int hd = idx & 511, m = idx >> 9; const bf16* ga = proj + (size_t)m * PW + PGA;
        float z = ba[hd];
#pragma unroll
        for (int r = 0; r < 16; ++r) z += bf1(ga[r]) * wa2[r * 512 + hd];
        const float ls = fminf(z, 0.f) - log1pf(__expf(-fabsf(z)));
        LA[idx] = ls * (1.f / 16.f);
    }
}
template <int L> __device__ __forceinline__ void p_cmp2_g(const Args& a, LAS unsigned char* lds) {
    const float* chid = (const float*)(a.ws + WS_CHID); float* KC = (float*)(a.ws + WS_KC);
    for (int t = blockIdx.x; t < 2 * 16; t += gridDim.x) {
        const int kind = t >> 4, tm = t & 15;
        const float* W2 = a.in[kind ? I_CW2V : I_CW2K] + (size_t)L * 256 * 128;
        auto al = [&](int r, int k) -> f32x4 { return *(const f32x4*)(chid + ((size_t)kind * NCR + r) * 256 + k); };
        auto bl = [&](int k, int n, int) -> f32x4 { return *(const f32x4*)(W2 + (size_t)k * 128 + n); };
        bf16* KCB = (bf16*)(a.ws + WS_KCB); bf16* VCT = (bf16*)(a.ws + WS_VCT);
        auto ep = [&](int r, int n, f32x4 v, f32x4) { *(f32x4*)(KC + ((size_t)kind * NCR + r) * 128 + n) = v;
            if (kind == 0) st_bf4(KCB + (size_t)r * 128 + n, v);
            else { bf16* vp = VCT + (size_t)((r >> 8) * 128 + n) * 256 + (r & 240) + vperm16(r & 15); vp[0] = (bf16)f2bf(v.x); vp[256] = (bf16)f2bf(v.y); vp[512] = (bf16)f2bf(v.z); vp[768] = (bf16)f2bf(v.w); } };
        ggemm_tile<false>((LAS float*)lds, tm * 128, 0, 256, al, bl, ep);
    }
}

__device__ __forceinline__ void dot4_bf(const bf16* kr, const LAS float* qs, float& s0, float& s1, float& s2, float& s3) {
    s0 = s1 = s2 = s3 = 0.f;
#pragma unroll 4
    for (int d8 = 0; d8 < 16; ++d8) {
        const u32x4 raw = *(const u32x4*)(kr + d8 * 8);
        const float kv[8] = {bflo(raw.x), bfhi(raw.x), bflo(raw.y), bfhi(raw.y), bflo(raw.z), bfhi(raw.z), bflo(raw.w), bfhi(raw.w)};
#pragma unroll
        for (int hf = 0; hf < 2; ++hf) {
            const f32x4 q0 = *(const LAS f32x4*)(qs + d8 * 8 + hf * 4), q1 = *(const LAS f32x4*)(qs + 128 + d8 * 8 + hf * 4), q2 = *(const LAS f32x4*)(qs + 256 + d8 * 8 + hf * 4), q3 = *(const LAS f32x4*)(qs + 384 + d8 * 8 + hf * 4);
            const float k0 = kv[hf * 4], k1 = kv[hf * 4 + 1], k2 = kv[hf * 4 + 2], k3 = kv[hf * 4 + 3];
            s0 += k0 * q0.x + k1 * q0.y + k2 * q0.z + k3 * q0.w; s1 += k0 * q1.x + k1 * q1.y + k2 * q1.z + k3 * q1.w;
            s2 += k0 * q2.x + k1 * q2.y + k2 * q2.z + k3 * q2.w; s3 += k0 * q3.x + k1 * q3.y + k2 * q3.z + k3 * q3.w;
        }
    }
}
__device__ __forceinline__ void dot4_f32(const float* kr, const LAS float* qs, float& s0, float& s1, float& s2, float& s3) {
    s0 = s1 = s2 = s3 = 0.f;
#pragma unroll 4
    for (int d4 = 0; d4 < 32; ++d4) {
        const f32x4 k = *(const f32x4*)(kr + d4 * 4);
        const f32x4 q0 = *(const LAS f32x4*)(qs + d4 * 4), q1 = *(const LAS f32x4*)(qs + 128 + d4 * 4), q2 = *(const LAS f32x4*)(qs + 256 + d4 * 4), q3 = *(const LAS f32x4*)(qs + 384 + d4 * 4);
        s0 += k.x * q0.x + k.y * q0.y + k.z * q0.z + k.w * q0.w; s1 += k.x * q1.x + k.y * q1.y + k.z * q1.z + k.w * q1.w;
        s2 += k.x * q2.x + k.y * q2.y + k.z * q2.z + k.w * q2.w; s3 += k.x * q3.x + k.y * q3.y + k.z * q3.z + k.w * q3.w;
    }
}
__device__ __forceinline__ void wave_softmax4(LAS float* sc, int nent, int lane) {
#pragma unroll
    for (int g = 0; g < 4; ++g) {
        LAS float* r = sc + g * 1024;
        float mx = -INFINITY;
        for (int i = lane; i < nent; i += 64) mx = fmaxf(mx, r[i]);
        mx = wave_max(mx);
        float sum = 0.f;
        for (int i = lane; i < nent; i += 64) { const float e = __expf(r[i] - mx); r[i] = e; sum += e; }
        sum = wave_sum(sum);
        const float inv = 1.f / sum;
        for (int i = lane; i < nent; i += 64) r[i] *= inv;
    }
}
__device__ __forceinline__ void p_nsa_g(const Args& a, LAS unsigned char* lds) {
    const int lane_ = threadIdx.x & 63, wave = __builtin_amdgcn_readfirstlane(threadIdx.x >> 6);
    LAS float* sc = (LAS float*)(lds + wave * 18432);
    LAS float* qs = sc + 4096;
    const bf16* proj = (const bf16*)(a.ws + WS_PROJ);
    const float* KC = (const float*)(a.ws + WS_KC);
    const float* rope = (const float*)(a.ws + WS_ROPE);
    bf16* mix = (bf16*)(a.ws + WS_MIX);
    const int gw = blockIdx.x * 8 + wave, NGW = gridDim.x * 8;
    for (int u = gw; u < NB * T * 2; u += NGW) {
        const int h = u & 1, t = (u >> 1) & (T - 1), b = u >> 13, m = b * T + t;
        int lane = lane_; asm volatile("" : "+v"(lane));
        const bf16* prow = proj + (size_t)m * PW;
        float qv[8];
        { const u32x4 raw = *(const u32x4*)(prow + PQ + h * 512 + lane * 8);
          qv[0] = bflo(raw.x); qv[1] = bfhi(raw.x); qv[2] = bflo(raw.y); qv[3] = bfhi(raw.y); qv[4] = bflo(raw.z); qv[5] = bfhi(raw.z); qv[6] = bflo(raw.w); qv[7] = bfhi(raw.w); }
#pragma unroll
        for (int i = 0; i < 8; ++i) qs[lane * 8 + i] = qv[i] * QSCALE;
        const int ncv = (t >= 31) ? ((t - 31) >> 4) + 1 : 0;
        const float* kcb = KC + (size_t)((b * 2 + h) * 256) * 128; const float* vcb = kcb + (size_t)NCR * 128;
        float oc[4][2] = {{0.f, 0.f}, {0.f, 0.f}, {0.f, 0.f}, {0.f, 0.f}};
        if (ncv > 0) {
#pragma unroll
            for (int j = 0; j < 4; ++j) { const int c = lane + 64 * j; float s0 = -INFINITY, s1 = -INFINITY, s2 = -INFINITY, s3 = -INFINITY;
                if (c < ncv) dot4_f32(kcb + (size_t)c * 128, qs, s0, s1, s2, s3);
                sc[c] = s0; sc[1024 + c] = s1; sc[2048 + c] = s2; sc[3072 + c] = s3; }
            wave_softmax4(sc, 256, lane);
            for (int c = 0; c < ncv; ++c) { const f32x2 v = *(const f32x2*)(vcb + (size_t)c * 128 + 2 * lane);
#pragma unroll
                for (int g = 0; g < 4; ++g) { const float p = sc[g * 1024 + c]; oc[g][0] += p * v.x; oc[g][1] += p * v.y; } }
        } else {
#pragma unroll
            for (int j = 0; j < 4; ++j) { const int c = lane + 64 * j; sc[c] = 0.f; sc[1024 + c] = 0.f; sc[2048 + c] = 0.f; sc[3072 + c] = 0.f; }
        }
        unsigned long long sel;
        { const int n = lane, cur = t >> 6; float imp = 0.f;
#pragma unroll
          for (int g = 0; g < 4; ++g)
#pragma unroll
              for (int cc = -1; cc < 4; ++cc) { const int c = 4 * n + cc; if (c >= 0 && c < 255) imp += sc[g * 1024 + c]; }
          const float iv = (n > cur) ? -INFINITY : ((n == 0 || n == cur || n == cur - 1) ? 1e9f : imp);
          int rank = 0;
          for (int m2 = 0; m2 < 64; ++m2) { const float v = __shfl(iv, m2); rank += ((v > iv) || (v == iv && m2 < n)) ? 1 : 0; }
          sel = __ballot(rank < 16); }
        { const int l16 = lane & 15; float part[8];
#pragma unroll
          for (int i = 0; i < 8; ++i) part[i] = __shfl_xor(qv[i], 2);
          if (l16 < 4) { const int ib = (l16 & 1) * 8; const bool lo = l16 < 2;
#pragma unroll
              for (int i = 0; i < 8; ++i) { const float c = rope[t * 32 + ib + i], s = rope[t * 32 + 16 + ib + i]; qv[i] = lo ? (qv[i] * c - part[i] * s) : (qv[i] * c + part[i] * s); } }
#pragma unroll
          for (int i = 0; i < 8; ++i) qs[lane * 8 + i] = qv[i] * QSCALE; }
        float os[4][2] = {{0.f, 0.f}, {0.f, 0.f}, {0.f, 0.f}, {0.f, 0.f}};
        { unsigned long long rem = sel; int jj = 0;
          while (rem) { const int n = __builtin_ctzll(rem); rem &= rem - 1; const int key = n * 64 + lane;
              float s0 = -INFINITY, s1 = -INFINITY, s2 = -INFINITY, s3 = -INFINITY;
              if (key <= t) dot4_bf(proj + (size_t)(b * T + key) * PW + PKS + h * 128, qs, s0, s1, s2, s3);
              sc[jj * 64 + lane] = s0; sc[1024 + jj * 64 + lane] = s1; sc[2048 + jj * 64 + lane] = s2; sc[3072 + jj * 64 + lane] = s3; ++jj; }
          wave_softmax4(sc, jj * 64, lane);
          rem = sel; jj = 0;
          while (rem) { const int n = __builtin_ctzll(rem); rem &= rem - 1;
              const int kmax = min(63, t - n * 64);
              for (int i = 0; i <= kmax; ++i) { const unsigned vw = *(const unsigned*)(proj + (size_t)(b * T + n * 64 + i) * PW + PVS + h * 128 + 2 * lane); const float v0 = bflo(vw), v1 = bfhi(vw);
#pragma unroll
                  for (int g = 0; g < 4; ++g) { const float p = sc[g * 1024 + jj * 64 + i]; os[g][0] += p * v0; os[g][1] += p * v1; } }
              ++jj; } }
        float ow[4][2] = {{0.f, 0.f}, {0.f, 0.f}, {0.f, 0.f}, {0.f, 0.f}};
        { const int t0 = max(0, t - 511), nk = t - t0 + 1, nb64 = (nk + 63) >> 6;
          for (int j = 0; j < nb64; ++j) { const int i = j * 64 + lane; float s0 = -INFINITY, s1 = -INFINITY, s2 = -INFINITY, s3 = -INFINITY;
              if (i < nk) dot4_bf(proj + (size_t)(b * T + t0 + i) * PW + PKW + h * 128, qs, s0, s1, s2, s3);
              sc[i] = s0; sc[1024 + i] = s1; sc[2048 + i] = s2; sc[3072 + i] = s3; }
          wave_softmax4(sc, nb64 * 64, lane);
          for (int i = 0; i < nk; ++i) { const unsigned vw = *(const unsigned*)(proj + (size_t)(b * T + t0 + i) * PW + PVW + h * 128 + 2 * lane); const float v0 = bflo(vw), v1 = bfhi(vw);
#pragma unroll
              for (int g = 0; g < 4; ++g) { const float p = sc[g * 1024 + i]; ow[g][0] += p * v0; ow[g][1] += p * v1; } } }
#pragma unroll
        for (int g = 0; g < 4; ++g) { const bf16* gp = prow + PNG + (h * 4 + g) * 3; const float g0 = sigmoidf_(bf1(gp[0])), g1 = sigmoidf_(bf1(gp[1])), g2 = sigmoidf_(bf1(gp[2]));
            const float o0 = g0 * oc[g][0] + g1 * os[g][0] + g2 * ow[g][0], o1 = g0 * oc[g][1] + g1 * os[g][1] + g2 * ow[g][1];
            *(unsigned*)(mix + (size_t)m * 2048 + (h * 4 + g) * 128 + 2 * lane) = pk2(o0, o1); }
    }
}

__device__ __forceinline__ void p_gla_g(const Args& a) {
    const int lane = threadIdx.x & 63, wave = __builtin_amdgcn_readfirstlane(threadIdx.x >> 6);
    const bf16* proj = (const bf16*)(a.ws + WS_PROJ); const float* LA = (const float*)(a.ws + WS_LA); float* glao = (float*)(a.ws + WS_GLAO);
    const int gw = blockIdx.x * 8 + wave, NGW = gridDim.x * 8;
    for (int u = gw; u < 2048; u += NGW) {
        const int e0 = (u & 127) * 2, h = (u >> 7) & 3, b = u >> 9;
        float S00 = 0.f, S01 = 0.f, S10 = 0.f, S11 = 0.f;
#pragma unroll 1
        for (int t0 = 0; t0 < T; t0 += 8) {
            float q0[8], q1[8], k0[8], k1[8], a0[8], a1[8]; unsigned vv[8];
#pragma unroll
            for (int s = 0; s < 8; ++s) { const size_t m = (size_t)b * T + t0 + s; const bf16* pr = proj + m * PW;
                q0[s] = bf1(pr[PGQ + h * 128 + lane]); q1[s] = bf1(pr[PGQ + h * 128 + 64 + lane]); k0[s] = bf1(pr[PGK + h * 128 + lane]); k1[s] = bf1(pr[PGK + h * 128 + 64 + lane]);
                a0[s] = LA[m * 512 + h * 128 + lane]; a1[s] = LA[m * 512 + h * 128 + 64 + lane]; vv[s] = *(const unsigned*)(pr + PGV + h * 256 + e0); }
            float r0[8], r1[8];
#pragma unroll
            for (int s = 0; s < 8; ++s) { const float d0 = __expf(a0[s]), d1 = __expf(a1[s]), v0 = bflo(vv[s]), v1 = bfhi(vv[s]);
                S00 = d0 * S00 + k0[s] * v0; S01 = d0 * S01 + k0[s] * v1; S10 = d1 * S10 + k1[s] * v0; S11 = d1 * S11 + k1[s] * v1;
                r0[s] = q0[s] * S00 + q1[s] * S10; r1[s] = q0[s] * S01 + q1[s] * S11; }
#pragma unroll
            for (int s = 0; s < 8; ++s) { r0[s] = wave_sum(r0[s]); r1[s] = wave_sum(r1[s]); }
#pragma unroll
            for (int s = 0; s < 8; ++s) if (lane == s) { f32x2 o; o.x = r0[s] * QSCALE; o.y = r1[s] * QSCALE; *(f32x2*)(glao + ((size_t)b * T + t0 + s) * 1024 + h * 256 + e0) = o; }
        }
    }
}
template <int L> __device__ __forceinline__ void p_glapost(const Args& a) {
    const int lane = threadIdx.x & 63, wave = __builtin_amdgcn_readfirstlane(threadIdx.x >> 6);
    const bf16* proj = (const bf16*)(a.ws + WS_PROJ); const float* glao = (const float*)(a.ws + WS_GLAO); bf16* mix = (bf16*)(a.ws + WS_MIX);
    const float* nw = a.in[I_GNW] + (size_t)L * 256;
    const int gw = blockIdx.x * 8 + wave, NGW = gridDim.x * 8;
    const f32x4 w4 = *(const f32x4*)(nw + lane * 4);
    for (int u = gw; u < M * 4; u += NGW) {
        const int h = u & 3, m = u >> 2;
        const f32x4 o = *(const f32x4*)(glao + (size_t)m * 1024 + h * 256 + lane * 4);
        const float ss = wave_sum(o.x * o.x + o.y * o.y + o.z * o.z + o.w * o.w);
        const float r = 1.f / sqrtf(ss * (1.f / 256.f) + NORM_EPS);
        const f32x4 gg = ld_bf4(proj + (size_t)m * PW + PGG + h * 256 + lane * 4);
        f32x4 y; y.x = o.x * r * w4.x * siluf_(gg.x); y.y = o.y * r * w4.y * siluf_(gg.y); y.z = o.z * r * w4.z * siluf_(gg.z); y.w = o.w * r * w4.w * siluf_(gg.w);
        st_bf4(mix + (size_t)m * 2048 + 1024 + h * 256 + lane * 4, y);
    }
}
template <int L> __device__ __forceinline__ void p_outproj_g(const Args& a, LAS unsigned char* lds, const float* xin, float* xout) {
    const float* mod = (const float*)(a.ws + WS_MOD) + (size_t)L * 4 * D6;
    const float* W = a.in[I_WOUT] + (size_t)L * 2048 * D; const bf16* mix = (const bf16*)(a.ws + WS_MIX);
    auto al = [&](int m, int k) -> f32x4 { return ld_bf4(mix + (size_t)m * 2048 + k); };
    auto bl = [&](int k, int n, int) -> f32x4 { return *(const f32x4*)(W + (size_t)k * D + n); };
    auto ep = [&](int m, int n, f32x4 v, f32x4) { const f32x4 g = *(const f32x4*)(mod + (size_t)(m >> 12) * D6 + 4096 + n); const f32x4 x = *(const f32x4*)(xin + (size_t)m * D + n);
        *(f32x4*)(xout + (size_t)m * D + n) = ALPHA * x + (1.f + g) * v; };
    for (int t = blockIdx.x; t < (M / 128) * (D / 128); t += gridDim.x) { const int tm = t >> 4, tn = t & 15; ggemm_tile<false>((LAS float*)lds, tm * 128, tn * 128, 2048, al, bl, ep); }
}
__device__ __forceinline__ void ln_regs(f32x4 (&v)[8], const float* g, const float* bt, int lane) {
    float s = 0.f;
#pragma unroll
    for (int j = 0; j < 8; ++j) s += (v[j].x + v[j].y) + (v[j].z + v[j].w);
    const float mean = wave_sum(s) * (1.f / D); float s2 = 0.f;
#pragma unroll
    for (int j = 0; j < 8; ++j) { v[j] = v[j] - mean; s2 += (v[j].x * v[j].x + v[j].y * v[j].y) + (v[j].z * v[j].z + v[j].w * v[j].w); }
    const float rstd = 1.f / sqrtf(wave_sum(s2) * (1.f / D) + LN_EPS);
#pragma unroll
    for (int j = 0; j < 8; ++j) { const f32x4 gv = *(const f32x4*)(g + j * 256 + lane * 4), bv = *(const f32x4*)(bt + j * 256 + lane * 4); v[j] = v[j] * rstd * gv + bv; }
}
template <int L, bool ROUTER, bool WRITE_HB> __device__ __forceinline__ void p_ln_mix(const Args& a, LAS unsigned char* lds, XT* X) {
    const int lane_ = threadIdx.x & 63, wave = __builtin_amdgcn_readfirstlane(threadIdx.x >> 6), tid = threadIdx.x;
    const float* g = a.in[I_LMG] + (size_t)L * D; const float* bt = a.in[I_LMB] + (size_t)L * D;
    const float* mod = (const float*)(a.ws + WS_MOD) + (size_t)L * 4 * D6;
    int* route_e = (int*)(a.ws + WS_ROUTE); float* route_w = (float*)(a.ws + WS_ROUTE + 128 * 1024); int* hist = (int*)(a.ws + WS_ROUTE + 384 * 1024);
    LAS int* el = (LAS int*)lds;
    const float* wr = a.in[I_MR];
    for (int chunk = blockIdx.x; chunk < 256; chunk += gridDim.x) {
        f32x4 v[8]; XRaw vn[8];
#pragma unroll
        for (int j = 0; j < 8; ++j) v[j] = xr2f(ldxr(X + (size_t)(chunk * 64 + wave * 8) * D + j * 256 + lane_ * 4));
#pragma unroll 1
        for (int r = 0; r < 8; ++r) {
            int lane = lane_; asm volatile("" : "+v"(lane));
            const int m = chunk * 64 + wave * 8 + r; XT* xr = X + (size_t)m * D;
            if (r < 7) {
#pragma unroll
                for (int j = 0; j < 8; ++j) vn[j] = ldxr(xr + D + j * 256 + lane * 4); }
            ln_regs(v, g, bt, lane);
#pragma unroll
            for (int j = 0; j < 8; ++j) stx4(xr + j * 256 + lane * 4, v[j]);
            if (WRITE_HB) { const float* md = mod + (size_t)(m >> 12) * D6; bf16* hb = (bf16*)(a.ws + WS_HB) + (size_t)m * D;
                f32x4 shv[8], scv[8];
#pragma unroll
                for (int j = 0; j < 8; ++j) { const int k = j * 256 + lane * 4; shv[j] = *(const f32x4*)(md + 6144 + k); scv[j] = *(const f32x4*)(md + 8192 + k); }
                __builtin_amdgcn_sched_barrier(0);
#pragma unroll
                for (int j = 0; j < 8; ++j) { const int k = j * 256 + lane * 4; const f32x4 hv = v[j] * (1.f + scv[j]) + shv[j];
                    if (FFN8_GU) *(unsigned*)((unsigned char*)(a.ws + WS_HB) + (size_t)m * D + k) = pk4_fp8(hv.x, hv.y, hv.z, hv.w); else st_bf4(hb + k, hv); }
                __builtin_amdgcn_sched_barrier(0); }
            if (ROUTER) {
                const float* md = mod + (size_t)(m >> 12) * D6;
                float lg[8] = {0.f, 0.f, 0.f, 0.f, 0.f, 0.f, 0.f, 0.f};
#pragma unroll
                for (int j = 0; j < 8; ++j) { const int k = j * 256 + lane * 4; const f32x4 sh = *(const f32x4*)(md + 6144 + k), scf = *(const f32x4*)(md + 8192 + k); const f32x4 hv = v[j] * (1.f + scf) + sh;
#pragma unroll
                    for (int i = 0; i < 4; ++i) { const f32x4 w0 = *(const f32x4*)(wr + (size_t)(k + i) * 8), w1 = *(const f32x4*)(wr + (size_t)(k + i) * 8 + 4); const float hx = hv[i];
                        lg[0] += hx * w0.x; lg[1] += hx * w0.y; lg[2] += hx * w0.z; lg[3] += hx * w0.w; lg[4] += hx * w1.x; lg[5] += hx * w1.y; lg[6] += hx * w1.z; lg[7] += hx * w1.w; } }
#pragma unroll
                for (int e = 0; e < 8; ++e) lg[e] = wave_sum(lg[e]);
                int i0 = 0; float v0 = lg[0];
#pragma unroll
                for (int e = 1; e < 8; ++e) if (lg[e] > v0) { v0 = lg[e]; i0 = e; }
                int i1 = -1; float v1 = -INFINITY;
#pragma unroll
                for (int e = 0; e < 8; ++e) if (e != i0 && lg[e] > v1) { v1 = lg[e]; i1 = e; }
                const float ex = __expf(v1 - v0), w0 = 1.f / (1.f + ex), w1 = ex / (1.f + ex);
                if (lane == 0) { route_e[m * 2] = i0; route_e[m * 2 + 1] = i1; route_w[m * 2] = w0; route_w[m * 2 + 1] = w1; el[(wave * 8 + r) * 2] = i0; el[(wave * 8 + r) * 2 + 1] = i1; }
            }
#pragma unroll
            for (int j = 0; j < 8; ++j) v[j] = xr2f(vn[j]);
        }
        if (ROUTER) {
            __syncthreads();
            if (tid < 8) { int cnt = 0; for (int i = 0; i < 128; ++i) cnt += (el[i] == tid) ? 1 : 0; hist[chunk * 8 + tid] = cnt; }
            __syncthreads();
        }
    }
}
template <int L> __device__ __forceinline__ void p_moe_slots(const Args& a, LAS unsigned char* lds, const XT* X) {
    const int lane = threadIdx.x & 63, wave = __builtin_amdgcn_readfirstlane(threadIdx.x >> 6), tid = threadIdx.x;
    const float* mod = (const float*)(a.ws + WS_MOD) + (size_t)L * 4 * D6;
    const int* route_e = (const int*)(a.ws + WS_ROUTE); int* tok_slot = (int*)(a.ws + WS_ROUTE + 256 * 1024); const int* hist = (const int*)(a.ws + WS_ROUTE + 384 * 1024);
    int* moe_base = (int*)(a.ws + WS_ROUTE + 512 * 1024); int* moe_cnt = moe_base + 16;
    bf16* hperm = (bf16*)(a.ws + WS_HPERM);
    LAS int* hl = (LAS int*)lds; LAS int* totl = hl + 2048; LAS int* befl = totl + 8; LAS int* basel = befl + 8; LAS int* el = basel + 16; LAS int* sl = el + 128;
    for (int chunk = blockIdx.x; chunk < 256; chunk += gridDim.x) {
        __syncthreads();
        for (int i = tid; i < 2048; i += 512) hl[i] = hist[i];
        if (tid < 128) el[tid] = route_e[chunk * 128 + tid];
        __syncthreads();
        { int sv = 0, bv = 0;
#pragma unroll
          for (int k = 0; k < 4; ++k) { const int c = 4 * lane + k; const int v = hl[c * 8 + wave]; sv += v; bv += (c < chunk) ? v : 0; }
#pragma unroll
          for (int o = 1; o < 64; o <<= 1) { sv += __shfl_xor(sv, o); bv += __shfl_xor(bv, o); }
          if (lane == 0) { totl[wave] = sv; befl[wave] = bv; } }
        __syncthreads();
        if (tid == 0) { int base = 0; for (int e = 0; e < 8; ++e) { basel[e] = base; base += (totl[e] + 255) & ~255; } basel[8] = base;
            if (chunk == 0) { for (int e = 0; e < 9; ++e) moe_base[e] = basel[e]; for (int e = 0; e < 8; ++e) moe_cnt[e] = totl[e]; } }
        __syncthreads();
        if (tid < 128) { const int e = el[tid]; int cnt = 0; for (int j = 0; j < tid; ++j) cnt += (el[j] == e) ? 1 : 0;
            const int slot = basel[e] + befl[e] + cnt; sl[tid] = slot; tok_slot[chunk * 128 + tid] = slot; }
        __syncthreads();
        f32x4 v[8], shv[8], scv[8]; XRaw vn[8];
        { const XT* xr = X + (size_t)(chunk * 64 + wave * 8) * D;
#pragma unroll
          for (int j = 0; j < 8; ++j) v[j] = xr2f(ldxr(xr + j * 256 + lane * 4)); }
#pragma unroll 1
        for (int tt = 0; tt < 8; ++tt) {
            const int tk = wave * 8 + tt, m = chunk * 64 + tk; const float* md = mod + (size_t)(m >> 12) * D6; const int s0 = sl[2 * tk], s1 = sl[2 * tk + 1];
            if (tt < 7) { const XT* xn = X + (size_t)(m + 1) * D;
#pragma unroll
                for (int j = 0; j < 8; ++j) vn[j] = ldxr(xn + j * 256 + lane * 4); }
#pragma unroll
            for (int j = 0; j < 8; ++j) { const int k = j * 256 + lane * 4; shv[j] = *(const f32x4*)(md + 6144 + k); scv[j] = *(const f32x4*)(md + 8192 + k); }
            __builtin_amdgcn_sched_barrier(0);
#pragma unroll
            for (int j = 0; j < 8; ++j) { const int k = j * 256 + lane * 4; const f32x4 hv = v[j] * (1.f + scv[j]) + shv[j];
                if (MOE_FP8 && FAST_GEMM) { const unsigned pk = pk4_fp8(hv.x, hv.y, hv.z, hv.w); *(unsigned*)((unsigned char*)hperm + (size_t)s0 * D + k) = pk; *(unsigned*)((unsigned char*)hperm + (size_t)s1 * D + k) = pk; }
                else { st_bf4(hperm + (size_t)s0 * D + k, hv); st_bf4(hperm + (size_t)s1 * D + k, hv); } }
#pragma unroll
            for (int j = 0; j < 8; ++j) v[j] = xr2f(vn[j]);
        }
    }
}
__device__ __forceinline__ void p_moe_gateup_g(const Args& a, LAS unsigned char* lds) {
    const int* moe_base = (const int*)(a.ws + WS_ROUTE + 512 * 1024); const int* moe_cnt = moe_base + 16;
    const bf16* hperm = (const bf16*)(a.ws + WS_HPERM); bf16* hid = (bf16*)(a.ws + WS_HID);
    const int R = moe_base[8], ntm = R / 128;
    for (int t = blockIdx.x; t < ntm * 56; t += gridDim.x) {
        const int tm = t / 56, tn = t % 56, row0 = tm * 128;
        int e = 0;
#pragma unroll
        for (int j = 1; j < 8; ++j) if (row0 >= moe_base[j]) e = j;
        if (row0 >= moe_base[e] + moe_cnt[e]) continue;
        const float* Wg = a.in[I_MWG] + (size_t)e * D * DFE; const float* Wu = a.in[I_MWU] + (size_t)e * D * DFE;
        auto al = [&](int r, int k) -> f32x4 { return ld_bf4(hperm + (size_t)r * D + k); };
        auto bl = [&](int k, int n, int which) -> f32x4 { return *(const f32x4*)((which ? Wu : Wg) + (size_t)k * DFE + n); };
        auto ep = [&](int r, int n, f32x4 gq, f32x4 uq) { f32x4 o; o.x = siluf_(gq.x) * uq.x; o.y = siluf_(gq.y) * uq.y; o.z = siluf_(gq.z) * uq.z; o.w = siluf_(gq.w) * uq.w; st_bf4(hid + (size_t)r * DFE + n, o); };
        ggemm_tile<true>((LAS float*)lds, row0, tn * 128, D, al, bl, ep);
    }
}
__device__ __forceinline__ void p_moe_down_g(const Args& a, LAS unsigned char* lds) {
    const int* moe_base = (const int*)(a.ws + WS_ROUTE + 512 * 1024); const int* moe_cnt = moe_base + 16;
    const bf16* hid = (const bf16*)(a.ws + WS_HID); float* Y = (float*)(a.ws + WS_Y);
    const int R = moe_base[8], ntm = R / 128;
    for (int t = blockIdx.x; t < ntm * 16; t += gridDim.x) {
        const int tm = t >> 4, tn = t & 15, row0 = tm * 128;
        int e = 0;
#pragma unroll
        for (int j = 1; j < 8; ++j) if (row0 >= moe_base[j]) e = j;
        if (row0 >= moe_base[e] + moe_cnt[e]) continue;
        const float* Wd = a.in[I_MWD] + (size_t)e * DFE * D;
        auto al = [&](int r, int k) -> f32x4 { return ld_bf4(hid + (size_t)r * DFE + k); };
        auto bl = [&](int k, int n, int) -> f32x4 { return *(const f32x4*)(Wd + (size_t)k * D + n); };
        auto ep = [&](int r, int n, f32x4 v, f32x4) { *(f32x4*)(Y + (size_t)r * D + n) = v; };
        ggemm_tile<false>((LAS float*)lds, row0, tn * 128, DFE, al, bl, ep);
    }
}
template <int L> __device__ __forceinline__ void p_moe_combine_ln(const Args& a, const XT* X, float* out) {
    const int lane_ = threadIdx.x & 63, wave = __builtin_amdgcn_readfirstlane(threadIdx.x >> 6);
    const float* mod = (const float*)(a.ws + WS_MOD) + (size_t)L * 4 * D6;
    const float* g = a.in[I_LFG] + (size_t)L * D; const float* bt = a.in[I_LFB] + (size_t)L * D;
    const float* route_w = (const float*)(a.ws + WS_ROUTE + 128 * 1024); const int* tok_slot = (const int*)(a.ws + WS_ROUTE + 256 * 1024); const float* Y = (const float*)(a.ws + WS_Y);
    const int gw = blockIdx.x * 8 + wave, NGW = gridDim.x * 8;
    constexpr bool YB = (MOE_FP8 && FAST_GEMM);
    int sa0 = 0, sa1 = 0, sb0 = 0, sb1 = 0; float wa0 = 0.f, wa1 = 0.f, wb0 = 0.f, wb1 = 0.f;
    if (gw < M) { sa0 = tok_slot[gw * 2]; sa1 = tok_slot[gw * 2 + 1]; wa0 = route_w[gw * 2]; wa1 = route_w[gw * 2 + 1]; }
    if (gw + NGW < M) { const int m1 = gw + NGW; sb0 = tok_slot[m1 * 2]; sb1 = tok_slot[m1 * 2 + 1]; wb0 = route_w[m1 * 2]; wb1 = route_w[m1 * 2 + 1]; }
    XRaw xv[8], xn[8]; u32x2 y0v[8], y1v[8], y0n[8], y1n[8];
    if (gw < M && YB) {
#pragma unroll
        for (int j = 0; j < 8; ++j) { const int k = j * 256 + lane_ * 4; xv[j] = ldxr(X + (size_t)gw * D + k); y0v[j] = *(const u32x2*)((const bf16*)Y + (size_t)sa0 * D + k); y1v[j] = *(const u32x2*)((const bf16*)Y + (size_t)sa1 * D + k); } }
#pragma unroll 1
    for (int m = gw; m < M; m += NGW) {
        int lane = lane_; asm volatile("" : "+v"(lane));
        const float* md = mod + (size_t)(m >> 12) * D6; const float w0 = wa0, w1 = wa1;
        f32x4 v[8];
        if (YB) {
            const int m1 = m + NGW, m2 = m + 2 * NGW;
            int sc0 = 0, sc1 = 0; float wc0 = 0.f, wc1 = 0.f;
            if (m2 < M) { sc0 = tok_slot[m2 * 2]; sc1 = tok_slot[m2 * 2 + 1]; wc0 = route_w[m2 * 2]; wc1 = route_w[m2 * 2 + 1]; }
            if (m1 < M) {
#pragma unroll
                for (int j = 0; j < 8; ++j) { const int k = j * 256 + lane * 4; xn[j] = ldxr(X + (size_t)m1 * D + k); y0n[j] = *(const u32x2*)((const bf16*)Y + (size_t)sb0 * D + k); y1n[j] = *(const u32x2*)((const bf16*)Y + (size_t)sb1 * D + k); } }
#pragma unroll
            for (int j = 0; j < 8; ++j) { const int k = j * 256 + lane * 4; const f32x4 gf = *(const f32x4*)(md + 10240 + k);
                const f32x4 ya = (f32x4){bflo(y0v[j].x), bfhi(y0v[j].x), bflo(y0v[j].y), bfhi(y0v[j].y)}, yb = (f32x4){bflo(y1v[j].x), bfhi(y1v[j].x), bflo(y1v[j].y), bfhi(y1v[j].y)};
                v[j] = ALPHA * xr2f(xv[j]) + (1.f + gf) * (w0 * ya + w1 * yb); }
#pragma unroll
            for (int j = 0; j < 8; ++j) { xv[j] = xn[j]; y0v[j] = y0n[j]; y1v[j] = y1n[j]; }
            sa0 = sb0; sa1 = sb1; wa0 = wb0; wa1 = wb1; sb0 = sc0; sb1 = sc1; wb0 = wc0; wb1 = wc1;
        } else {
            const float ww0 = route_w[m * 2], ww1 = route_w[m * 2 + 1];
            const float* y0 = Y + (size_t)tok_slot[m * 2] * D; const float* y1 = Y + (size_t)tok_slot[m * 2 + 1] * D; const XT* xr = X + (size_t)m * D;
#pragma unroll
            for (int j = 0; j < 8; ++j) { const int k = j * 256 + lane * 4; const f32x4 gf = *(const f32x4*)(md + 10240 + k); v[j] = ALPHA * xr2f(ldxr(xr + k)) + (1.f + gf) * (ww0 * *(const f32x4*)(y0 + k) + ww1 * *(const f32x4*)(y1 + k)); }
        }
        ln_regs(v, g, bt, lane);
#pragma unroll
        for (int j = 0; j < 8; ++j) *(f32x4*)(out + (size_t)m * D + j * 256 + lane * 4) = v[j];
    }
}
template <int L> __device__ __forceinline__ void p_ffn_gateup_g(const Args& a, LAS unsigned char* lds, const float* X) {
    const float* mod = (const float*)(a.ws + WS_MOD) + (size_t)L * 4 * D6;
    const float* Wg = a.in[I_FWG]; const float* Wu = a.in[I_FWU]; bf16* hid = (bf16*)(a.ws + WS_HID);
    auto al = [&](int m, int k) -> f32x4 { const float* md = mod + (size_t)(m >> 12) * D6; const f32x4 x = *(const f32x4*)(X + (size_t)m * D + k); const f32x4 sh = *(const f32x4*)(md + 6144 + k), scf = *(const f32x4*)(md + 8192 + k); return x * (1.f + scf) + sh; };
    auto bl = [&](int k, int n, int which) -> f32x4 { return *(const f32x4*)((which ? Wu : Wg) + (size_t)k * DFF + n); };
    auto ep = [&](int r, int n, f32x4 gq, f32x4 uq) { f32x4 o; o.x = siluf_(gq.x) * uq.x; o.y = siluf_(gq.y) * uq.y; o.z = siluf_(gq.z) * uq.z; o.w = siluf_(gq.w) * uq.w; st_bf4(hid + (size_t)r * DFF + n, o); };
    for (int t = blockIdx.x; t < (M / 128) * (DFF / 128); t += gridDim.x) { const int tm = t / (DFF / 128), tn = t % (DFF / 128); ggemm_tile<true>((LAS float*)lds, tm * 128, tn * 128, D, al, bl, ep); }
}
template <int L> __device__ __forceinline__ void p_ffn_down_g(const Args& a, LAS unsigned char* lds, const float* X, float* xout) {
    const float* mod = (const float*)(a.ws + WS_MOD) + (size_t)L * 4 * D6;
    const float* Wd = a.in[I_FWD]; const bf16* hid = (const bf16*)(a.ws + WS_HID);
    auto al = [&](int m, int k) -> f32x4 { return ld_bf4(hid + (size_t)m * DFF + k); };
    auto bl = [&](int k, int n, int) -> f32x4 { return *(const f32x4*)(Wd + (size_t)k * D + n); };
    auto ep = [&](int m, int n, f32x4 v, f32x4) { const f32x4 gf = *(const f32x4*)(mod + (size_t)(m >> 12) * D6 + 10240 + n); const f32x4 x = *(const f32x4*)(X + (size_t)m * D + n);
        *(f32x4*)(xout + (size_t)m * D + n) = ALPHA * x + (1.f + gf) * v; };
    for (int t = blockIdx.x; t < (M / 128) * (D / 128); t += gridDim.x) { const int tm = t >> 4, tn = t & 15; ggemm_tile<false>((LAS float*)lds, tm * 128, tn * 128, DFF, al, bl, ep); }
}
template <int L, bool NEXT_HB> __device__ __forceinline__ void p_ln_ffn(const Args& a, XT* X) {
    const float* modn = (const float*)(a.ws + WS_MOD) + (size_t)(L + 1) * 4 * D6;
    const int lane_ = threadIdx.x & 63, wave = __builtin_amdgcn_readfirstlane(threadIdx.x >> 6);
    const float* g = a.in[I_LFG] + (size_t)L * D; const float* bt = a.in[I_LFB] + (size_t)L * D;
    const int gw = blockIdx.x * 8 + wave, NGW = gridDim.x * 8;
    f32x4 v[8]; XRaw vn[8];
    if (gw < M) {
#pragma unroll
        for (int j = 0; j < 8; ++j) v[j] = xr2f(ldxr(X + (size_t)gw * D + j * 256 + lane_ * 4)); }
#pragma unroll 1
    for (int m = gw; m < M; m += NGW) { int lane = lane_; asm volatile("" : "+v"(lane)); XT* xr = X + (size_t)m * D; const int mn = m + NGW;
        if (mn < M) {
#pragma unroll
            for (int j = 0; j < 8; ++j) vn[j] = ldxr(X + (size_t)mn * D + j * 256 + lane * 4); }
        ln_regs(v, g, bt, lane);
#pragma unroll
        for (int j = 0; j < 8; ++j) stx4(xr + j * 256 + lane * 4, v[j]);
        if (NEXT_HB) { const float* md = modn + (size_t)(m >> 12) * D6; bf16* hb = (bf16*)(a.ws + WS_HB) + (size_t)m * D; f32x4 shv[8], scv[8];
#pragma unroll
            for (int j = 0; j < 8; ++j) { const int k = j * 256 + lane * 4; shv[j] = *(const f32x4*)(md + k); scv[j] = *(const f32x4*)(md + 2048 + k); }
            __builtin_amdgcn_sched_barrier(0);
#pragma unroll
            for (int j = 0; j < 8; ++j) st_bf4(hb + j * 256 + lane * 4, v[j] * (1.f + scv[j]) + shv[j]);
            __builtin_amdgcn_sched_barrier(0); }
#pragma unroll
        for (int j = 0; j < 8; ++j) v[j] = xr2f(vn[j]); }
}


typedef short bf16x8 __attribute__((ext_vector_type(8)));
typedef float f32x16 __attribute__((ext_vector_type(16)));
typedef short s16x4 __attribute__((ext_vector_type(4)));
constexpr int NK_ROW = 272, NV_ROW = 136, NBUF = 17408;
constexpr float SM_C = 0.08838834764831845f * 1.4426950408889634f;

typedef const GAS unsigned char* gcp;
template <class TT> __device__ __forceinline__ TT gld(gcp p) { return *(const GAS TT*)p; }
__device__ __forceinline__ gcp uniform_ptr(const void* p) { const unsigned long long v = (unsigned long long)p; const unsigned lo = __builtin_amdgcn_readfirstlane((unsigned)v), hi = __builtin_amdgcn_readfirstlane((unsigned)(v >> 32)); return (gcp)(((unsigned long long)hi << 32) | lo); }
__device__ __forceinline__ void nsa_ld2(const bf16* base, unsigned off, u32x4& k0, u32x4& k1) { const gcp p = uniform_ptr(base) + off; k0 = gld<u32x4>(p); k1 = gld<u32x4>(p + 16); }
__device__ __forceinline__ void nsa_st_k(LAS unsigned char* buf, int tid, u32x4 k0, u32x4 k1) { LAS unsigned char* q = buf + (tid >> 3) * NK_ROW + (tid & 7) * 32; *(LAS u32x4*)q = k0; *(LAS u32x4*)(q + 16) = k1; }

__device__ __forceinline__ void nsa_st_v(LAS unsigned char* buf, int tid, u32x4 v0, u32x4 v1) { LAS u32x2* q = (LAS u32x2*)(buf + (tid >> 2) * NV_ROW + (tid & 3) * 32); q[0] = (u32x2){v0.x, v0.y}; q[1] = (u32x2){v0.z, v0.w}; q[2] = (u32x2){v1.x, v1.y}; q[3] = (u32x2){v1.z, v1.w}; }
#ifndef NSA_QKB
#define NSA_QKB 2
#endif
__device__ __forceinline__ void nsa_qk(const LAS unsigned char* kbuf, const bf16x8 (&qf)[8], int r, int h, f32x16& p0, f32x16& p1) {
    const LAS unsigned char* kp = kbuf + r * NK_ROW + h * 16;
#pragma unroll
    for (int i = 0; i < 16; ++i) { p0[i] = 0.f; p1[i] = 0.f; }
    bf16x8 a0[NSA_QKB], a1[NSA_QKB], b0[NSA_QKB], b1[NSA_QKB];
#pragma unroll
    for (int k4 = 0; k4 < NSA_QKB; ++k4) { a0[k4] = *(const LAS bf16x8*)(kp + k4 * 32); a1[k4] = *(const LAS bf16x8*)(kp + 32 * NK_ROW + k4 * 32); }
    __builtin_amdgcn_sched_barrier(0);
#pragma unroll
    for (int kb = 0; kb < 8 / NSA_QKB; kb += 2) {
        if (kb + 1 < 8 / NSA_QKB) {
#pragma unroll
            for (int k4 = 0; k4 < NSA_QKB; ++k4) { b0[k4] = *(const LAS bf16x8*)(kp + (NSA_QKB * (kb + 1) + k4) * 32); b1[k4] = *(const LAS bf16x8*)(kp + 32 * NK_ROW + (NSA_QKB * (kb + 1) + k4) * 32); } }
        __builtin_amdgcn_sched_barrier(0);
#pragma unroll
        for (int k4 = 0; k4 < NSA_QKB; ++k4) { p0 = __builtin_amdgcn_mfma_f32_32x32x16_bf16(a0[k4], qf[NSA_QKB * kb + k4], p0, 0, 0, 0); p1 = __builtin_amdgcn_mfma_f32_32x32x16_bf16(a1[k4], qf[NSA_QKB * kb + k4], p1, 0, 0, 0); }
        __builtin_amdgcn_sched_barrier(0);
        if (kb + 2 < 8 / NSA_QKB) {
#pragma unroll
            for (int k4 = 0; k4 < NSA_QKB; ++k4) { a0[k4] = *(const LAS bf16x8*)(kp + (NSA_QKB * (kb + 2) + k4) * 32); a1[k4] = *(const LAS bf16x8*)(kp + 32 * NK_ROW + (NSA_QKB * (kb + 2) + k4) * 32); } }
        __builtin_amdgcn_sched_barrier(0);
        if (kb + 1 < 8 / NSA_QKB) {
#pragma unroll
            for (int k4 = 0; k4 < NSA_QKB; ++k4) { p0 = __builtin_amdgcn_mfma_f32_32x32x16_bf16(b0[k4], qf[NSA_QKB * (kb + 1) + k4], p0, 0, 0, 0); p1 = __builtin_amdgcn_mfma_f32_32x32x16_bf16(b1[k4], qf[NSA_QKB * (kb + 1) + k4], p1, 0, 0, 0); } }
        __builtin_amdgcn_sched_barrier(0);
    }
}
__device__ __forceinline__ bf16x8 nsa_pack8(const f32x16& p, int s) { u32x4 w; w.x = pg8::cvt_pk_bf16(p[8 * s + 0], p[8 * s + 1]); w.y = pg8::cvt_pk_bf16(p[8 * s + 2], p[8 * s + 3]); w.z = pg8::cvt_pk_bf16(p[8 * s + 4], p[8 * s + 5]); w.w = pg8::cvt_pk_bf16(p[8 * s + 6], p[8 * s + 7]); return __builtin_bit_cast(bf16x8, w); }
__device__ __forceinline__ void nsa_pv_rd(const LAS unsigned char* vbuf, int dt, int r, int h, bf16x8 (&af)[2][2]) {
#pragma unroll
    for (int kh = 0; kh < 2; ++kh)
#pragma unroll
        for (int ss = 0; ss < 2; ++ss) { const LAS unsigned char* vp = vbuf + (32 * dt + r) * NV_ROW + (32 * kh + 16 * ss) * 2 + 16 * h;
            const s16x4 lo = *(const LAS s16x4*)vp, hi = *(const LAS s16x4*)(vp + 8);
            af[kh][ss] = (bf16x8){lo[0], lo[1], lo[2], lo[3], hi[0], hi[1], hi[2], hi[3]}; }
}
__device__ __forceinline__ void nsa_pv_mm(const bf16x8 (&af)[2][2], const bf16x8 (&pf)[2][2], f32x16& o) {
#pragma unroll
    for (int kh = 0; kh < 2; ++kh)
#pragma unroll
        for (int ss = 0; ss < 2; ++ss) o = __builtin_amdgcn_mfma_f32_32x32x16_bf16(af[kh][ss], pf[kh][ss], o, 0, 0, 0);
}
#ifndef NSA_PV_PP
#define NSA_PV_PP 1
#endif
__device__ __forceinline__ void nsa_pv(const LAS unsigned char* vbuf, const bf16x8 (&pf)[2][2], f32x16 (&o)[4], int r, int h) {
#if !NSA_PV_PP
#pragma unroll
    for (int dt = 0; dt < 4; ++dt) { bf16x8 fa[2][2]; nsa_pv_rd(vbuf, dt, r, h, fa); __builtin_amdgcn_sched_barrier(0); nsa_pv_mm(fa, pf, o[dt]); __builtin_amdgcn_sched_barrier(0); }
    return;
#endif
    bf16x8 fa[2][2], fb[2][2];
    nsa_pv_rd(vbuf, 0, r, h, fa);
    __builtin_amdgcn_sched_barrier(0);
    nsa_pv_rd(vbuf, 1, r, h, fb);
    __builtin_amdgcn_sched_barrier(0);
    nsa_pv_mm(fa, pf, o[0]);
    __builtin_amdgcn_sched_barrier(0);
    nsa_pv_rd(vbuf, 2, r, h, fa);
    __builtin_amdgcn_sched_barrier(0);
    nsa_pv_mm(fb, pf, o[1]);
    __builtin_amdgcn_sched_barrier(0);
    nsa_pv_rd(vbuf, 3, r, h, fb);
    __builtin_amdgcn_sched_barrier(0);
    nsa_pv_mm(fa, pf, o[2]);
    __builtin_amdgcn_sched_barrier(0);
    nsa_pv_mm(fb, pf, o[3]);
    __builtin_amdgcn_sched_barrier(0);
}
__device__ __forceinline__ float nsa_rowmax(const f32x16& p0, const f32x16& p1) { float mx = fmaxf(p0[0], p1[0]);
#pragma unroll
    for (int i = 1; i < 16; ++i) mx = fmaxf(mx, fmaxf(p0[i], p1[i]));
    return mx; }


#ifndef NSA_DMA
#define NSA_DMA 1
#endif
constexpr int NRING = 3, NTB = 16384;
__device__ __forceinline__ void glds16(const void* gsrc, unsigned lds_dst) { unsigned keep;
    asm volatile("s_mov_b32 %0, m0\n\ts_mov_b32 m0, %2\n\ts_nop 0\n\tglobal_load_lds_dwordx4 %1, off\n\ts_mov_b32 m0, %0" : "=&s"(keep) : "v"(gsrc), "s"(lds_dst) : "memory"); }
__device__ __forceinline__ void nsa_dma_tile(const bf16* kt, unsigned kstr, const bf16* vt, unsigned vstr, unsigned ldsK, unsigned ldsV, int w, int lane) {
#pragma unroll
    for (int i = 0; i < 2; ++i) { const int q = 2 * w + i, row = 4 * q + (lane >> 4), c = (lane & 15) ^ (row & 15);
        glds16((const unsigned char*)kt + ((size_t)row * kstr + c * 16), (unsigned)__builtin_amdgcn_readfirstlane((int)(ldsK + q * 1024))); }
#pragma unroll
    for (int i = 0; i < 2; ++i) { const int q = 2 * w + i, row = 8 * q + (lane >> 3), c = (lane & 7) ^ ((row >> 1) & 7);
        glds16((const unsigned char*)vt + ((size_t)row * vstr + c * 16), (unsigned)__builtin_amdgcn_readfirstlane((int)(ldsV + q * 1024))); }
}
__device__ __forceinline__ void nsa_qk_sw(const LAS unsigned char* kbuf, const bf16x8 (&qf)[8], int r, int h, f32x16& p0, f32x16& p1) {
    const int x = r & 15; const LAS unsigned char* kA = kbuf + r * 256 + ((h ^ (x & 1)) * 16); const int xk = (x & 14) * 16;
#pragma unroll
    for (int i = 0; i < 16; ++i) { p0[i] = 0.f; p1[i] = 0.f; }
    bf16x8 a0, a1, b0, b1;
    a0 = *(const LAS bf16x8*)(kA + (0 ^ xk)); a1 = *(const LAS bf16x8*)(kA + (0 ^ xk) + 8192); __builtin_amdgcn_sched_barrier(0);
#pragma unroll
    for (int ks = 0; ks < 8; ks += 2) {
        b0 = *(const LAS bf16x8*)(kA + (((ks + 1) * 32) ^ xk)); b1 = *(const LAS bf16x8*)(kA + (((ks + 1) * 32) ^ xk) + 8192); __builtin_amdgcn_sched_barrier(0);
        p0 = __builtin_amdgcn_mfma_f32_32x32x16_bf16(a0, qf[ks], p0, 0, 0, 0); p1 = __builtin_amdgcn_mfma_f32_32x32x16_bf16(a1, qf[ks], p1, 0, 0, 0); __builtin_amdgcn_sched_barrier(0);
        if (ks + 2 < 8) { a0 = *(const LAS bf16x8*)(kA + (((ks + 2) * 32) ^ xk)); a1 = *(const LAS bf16x8*)(kA + (((ks + 2) * 32) ^ xk) + 8192); } __builtin_amdgcn_sched_barrier(0);
        p0 = __builtin_amdgcn_mfma_f32_32x32x16_bf16(b0, qf[ks + 1], p0, 0, 0, 0); p1 = __builtin_amdgcn_mfma_f32_32x32x16_bf16(b1, qf[ks + 1], p1, 0, 0, 0); __builtin_amdgcn_sched_barrier(0);
    }
}
__device__ __forceinline__ void nsa_pv_rd4(const LAS unsigned char* vA, int sv, int step, bf16x8 (&af)[4]) {
#pragma unroll
    for (int dt = 0; dt < 4; ++dt) af[dt] = *(const LAS bf16x8*)(vA + dt * 4096 + (((2 * step) * 16) ^ sv));
}
__device__ __forceinline__ void nsa_pv_mm4(const bf16x8 (&af)[4], const bf16x8& pfk, f32x16 (&o)[4]) {
#pragma unroll
    for (int dt = 0; dt < 4; ++dt) o[dt] = __builtin_amdgcn_mfma_f32_32x32x16_bf16(af[dt], pfk, o[dt], 0, 0, 0);
}
__device__ __forceinline__ void nsa_pv_sw(const LAS unsigned char* vbuf, const bf16x8 (&pf)[2][2], f32x16 (&o)[4], int r, int h) {
    const int sv = (((r >> 1) & 7) ^ h) * 16; const LAS unsigned char* vA = vbuf + r * 128;
#pragma unroll
    for (int step = 0; step < 4; ++step) { bf16x8 fa[4];
        nsa_pv_rd4(vA, sv, step, fa); __builtin_amdgcn_sched_barrier(0);
        nsa_pv_mm4(fa, pf[step >> 1][step & 1], o); __builtin_amdgcn_sched_barrier(0); }
}
__device__ __forceinline__ void nsa_unit(const Args& a, LAS unsigned char* lds, int b, int kvh, int qb) {
    const int tid = threadIdx.x, lane = tid & 63, w = __builtin_amdgcn_readfirstlane(tid >> 6), r = lane & 31, h = lane >> 5;
    const int ql = 8 * w + (r >> 2), g = r & 3, t = 64 * qb + ql; const size_t m = (size_t)b * T + t;
    const bf16* proj = (const bf16*)(a.ws + WS_PROJ);
    const gcp projU = uniform_ptr(proj); const unsigned prow_off = (unsigned)m * (unsigned)(PW * 2);
    const float NINF = -INFINITY;
    const unsigned offk = (unsigned)(((tid >> 3) * PW + (tid & 7) * 16) * 2), offv = (unsigned)(((tid >> 2) * VTP + (tid & 3) * 16) * 2);
    const unsigned offkc = (unsigned)(((tid >> 3) * 128 + (tid & 7) * 16) * 2), offvc = (unsigned)(((tid >> 2) * 256 + (tid & 3) * 16) * 2);
    constexpr int IMPW_OFF = NSA_DMA ? 7 * NTB : 4 * NBUF;
    LAS float* impw = (LAS float*)(lds + IMPW_OFF + w * 4096); LAS unsigned* selw = (LAS unsigned*)(lds + IMPW_OFF + 32768 + w * 64);
    bf16x8 qf[8];
    { const gcp qp = projU + (prow_off + (unsigned)((PQ + (kvh * 4 + g) * 128 + 8 * h) * 2));
#pragma unroll
      for (int ks = 0; ks < 8; ++ks) qf[ks] = gld<bf16x8>(qp + 32 * ks); }
    float g0, g1, g2; { const gcp gp = projU + (prow_off + (unsigned)((PNG + (kvh * 4 + g) * 3) * 2)); g0 = sigmoidf_(bf1(gld<bf16>(gp))); g1 = sigmoidf_(bf1(gld<bf16>(gp + 2))); g2 = sigmoidf_(bf1(gld<bf16>(gp + 4))); }
    const int tmax = 64 * qb + 63, ntc = ((((tmax - 31) >> 4) + 1) + 63) >> 6;
    const int ncv = (t >= 31) ? ((t - 31) >> 4) + 1 : 0;
    const bf16* kcb = (const bf16*)(a.ws + WS_KCB) + (size_t)((b * 2 + kvh) * 256) * 128; const bf16* vct = (const bf16*)(a.ws + WS_VCT) + (size_t)((b * 2 + kvh) * 128) * 256;
    __syncthreads();
#pragma unroll
    for (int ct = 0; ct < 4; ++ct) if (ct < ntc) { u32x4 k0, k1; nsa_ld2(kcb + (size_t)ct * 64 * 128, offkc, k0, k1); nsa_st_k(lds + ct * NBUF, tid, k0, k1); }
    __syncthreads();
    float mx = -1e30f, ls = 0.f;
#pragma unroll 1
    for (int ct = 0; ct < ntc; ++ct) { f32x16 s0, s1; nsa_qk(lds + ct * NBUF, qf, r, h, s0, s1);
#pragma unroll
        for (int i = 0; i < 16; ++i) { const int c0 = 64 * ct + (i & 3) + 8 * (i >> 2) + 4 * h; s0[i] = (c0 < ncv) ? s0[i] : NINF; s1[i] = (c0 + 32 < ncv) ? s1[i] : NINF; }
        float tmx = nsa_rowmax(s0, s1); tmx = fmaxf(tmx, __shfl_xor(tmx, 32));
        const float mnew = fmaxf(mx, tmx), alpha = __builtin_amdgcn_exp2f((mx - mnew) * SM_C), nmc = -mnew * SM_C; mx = mnew;
        float la = 0.f;
#pragma unroll
        for (int i = 0; i < 16; ++i) la += __builtin_amdgcn_exp2f(fmaf(s0[i], SM_C, nmc)) + __builtin_amdgcn_exp2f(fmaf(s1[i], SM_C, nmc));
        ls = ls * alpha + la; }
    ls += __shfl_xor(ls, 32);
    const float cinv = ls > 0.f ? 1.f / ls : 0.f, cnmc = -mx * SM_C;
    bf16x8 pfc[4][2][2];
#pragma unroll
    for (int ct = 0; ct < 4; ++ct) {
        f32x16 S2[2];
        if (ct < ntc) { nsa_qk(lds + ct * NBUF, qf, r, h, S2[0], S2[1]);
#pragma unroll
            for (int i = 0; i < 16; ++i) { const int c0 = 64 * ct + (i & 3) + 8 * (i >> 2) + 4 * h;
                S2[0][i] = (c0 < ncv) ? __builtin_amdgcn_exp2f(fmaf(S2[0][i], SM_C, cnmc)) * cinv : 0.f; S2[1][i] = (c0 + 32 < ncv) ? __builtin_amdgcn_exp2f(fmaf(S2[1][i], SM_C, cnmc)) * cinv : 0.f; }
        } else {
#pragma unroll
            for (int i = 0; i < 16; ++i) { S2[0][i] = 0.f; S2[1][i] = 0.f; } }
#pragma unroll
        for (int kh = 0; kh < 2; ++kh)
#pragma unroll
            for (int aa = 0; aa < 4; ++aa) { float G = (S2[kh][4 * aa] + S2[kh][4 * aa + 1]) + (S2[kh][4 * aa + 2] + S2[kh][4 * aa + 3]); float Lv = S2[kh][4 * aa + 3];
                G += __shfl_xor(G, 1); G += __shfl_xor(G, 2); Lv += __shfl_xor(Lv, 1); Lv += __shfl_xor(Lv, 2);
                const int n = 16 * ct + 8 * kh + 2 * aa + h;
                if (g == 0) { impw[(r >> 2) * 64 + n] = G; impw[512 + (r >> 2) * 64 + n] = Lv; } }
#pragma unroll
        for (int kh = 0; kh < 2; ++kh) { pfc[ct][kh][0] = nsa_pack8(S2[kh], 0); pfc[ct][kh][1] = nsa_pack8(S2[kh], 1); }
    }
    __syncthreads();
    u32x4 sv0[4], sv1[4];
#pragma unroll
    for (int ct = 0; ct < 4; ++ct) if (ct < ntc) nsa_ld2(vct + ct * 64, offvc, sv0[ct], sv1[ct]);
#pragma unroll 1
    for (int qq = 0; qq < 8; ++qq) {
        const float imp = impw[qq * 64 + lane] + (lane > 0 ? impw[512 + qq * 64 + lane - 1] : 0.f);
        const float iv = (lane > qb) ? NINF : ((lane == 0 || lane == qb || lane == qb - 1) ? 1e9f : imp);
        const unsigned ub = __builtin_bit_cast(unsigned, iv); unsigned key = (ub & 0x80000000u) ? ~ub : (ub | 0x80000000u); key = (key & ~63u) | (unsigned)(63 - lane);
        unsigned thr = 0u;
#pragma unroll
        for (int bit = 31; bit >= 0; --bit) { const unsigned cand = thr | (1u << bit); const int cnt = __builtin_popcountll(__ballot(key >= cand)); thr = (cnt >= 16) ? cand : thr; }
        const unsigned long long msk = __ballot(key >= thr);
        if (lane == 0) { selw[qq * 2] = (unsigned)msk; selw[qq * 2 + 1] = (unsigned)(msk >> 32); }
    }
    const unsigned long long selmask = (unsigned long long)selw[(r >> 2) * 2] | ((unsigned long long)selw[(r >> 2) * 2 + 1] << 32);
#pragma unroll
    for (int ct = 0; ct < 4; ++ct) if (ct < ntc) nsa_st_v(lds + ct * NBUF, tid, sv0[ct], sv1[ct]);
    __syncthreads();
    f32x16 o[4];
#pragma unroll
    for (int dt = 0; dt < 4; ++dt)
#pragma unroll
        for (int i = 0; i < 16; ++i) o[dt][i] = 0.f;
#pragma unroll
    for (int ct = 0; ct < 4; ++ct) if (ct < ntc) nsa_pv(lds + ct * NBUF, pfc[ct], o, r, h);
    GAS unsigned char* mp = (GAS unsigned char*)uniform_ptr(a.ws + WS_MIX) + ((unsigned)m * 4096u + (unsigned)(((kvh * 4 + g) * 128 + 4 * h) * 2));
#pragma unroll
    for (int dt = 0; dt < 4; ++dt)
#pragma unroll
        for (int aa = 0; aa < 4; ++aa) { u32x2 wv; wv.x = pg8::cvt_pk_bf16(o[dt][4 * aa] * g0, o[dt][4 * aa + 1] * g0); wv.y = pg8::cvt_pk_bf16(o[dt][4 * aa + 2] * g0, o[dt][4 * aa + 3] * g0); *(GAS u32x2*)(mp + (32 * dt + 8 * aa) * 2) = wv; }
    { const gcp rpb = uniform_ptr(a.ws + WS_ROPE) + (unsigned)((t * 32 + 8 * h) * 4);
      u32x4 w0 = __builtin_bit_cast(u32x4, qf[0]), w1 = __builtin_bit_cast(u32x4, qf[1]);
#pragma unroll
      for (int jj = 0; jj < 4; ++jj) { const float c0 = gld<float>(rpb + 8 * jj), c1 = gld<float>(rpb + 8 * jj + 4), s0 = gld<float>(rpb + 64 + 8 * jj), s1 = gld<float>(rpb + 64 + 8 * jj + 4);
          const float xa0 = bflo(w0[jj]), xa1 = bfhi(w0[jj]), xb0 = bflo(w1[jj]), xb1 = bfhi(w1[jj]);
          w0[jj] = pg8::cvt_pk_bf16(xa0 * c0 - xb0 * s0, xa1 * c1 - xb1 * s1); w1[jj] = pg8::cvt_pk_bf16(xb0 * c0 + xa0 * s0, xb1 * c1 + xa1 * s1); }
      qf[0] = __builtin_bit_cast(bf16x8, w0); qf[1] = __builtin_bit_cast(bf16x8, w1); }
    const int nS = qb + 1, jlo = qb > 8 ? qb - 8 : 0, nTot = nS + (qb - jlo + 1);
    const bf16* ksb = proj + (size_t)b * T * PW + PKS + kvh * 128; const bf16* kwb = proj + (size_t)b * T * PW + PKW + kvh * 128;
    const bf16* vsb = (const bf16*)(a.ws + WS_VTS) + (size_t)((b * 2 + kvh) * 128) * VTP; const bf16* vwb = (const bf16*)(a.ws + WS_VTW) + (size_t)((b * 2 + kvh) * 128) * VTP;
#if NSA_DMA
    const unsigned ldsb = (unsigned)(size_t)lds;
    constexpr int KRING = 3, VOFF = KRING * NTB;
    auto tile_src = [&](int i2, const bf16*& kt, const bf16*& vt) { if (i2 < nS) { kt = ksb + (size_t)(64 * i2) * PW; vt = vsb + 64 * i2; } else { const int j = jlo + i2 - nS; kt = kwb + (size_t)(64 * j) * PW; vt = vwb + 64 * j; } };
    __syncthreads();
    { const bf16 *kt, *vt; tile_src(0, kt, vt); nsa_dma_tile(kt, PW * 2, vt, VTP * 2, ldsb, ldsb + VOFF, w, lane);
      if (nTot > 1) { tile_src(1, kt, vt); nsa_dma_tile(kt, PW * 2, vt, VTP * 2, ldsb + NTB, ldsb + VOFF + NTB, w, lane); } }
#pragma unroll
    for (int dt = 0; dt < 4; ++dt)
#pragma unroll
        for (int i = 0; i < 16; ++i) o[dt][i] = 0.f;
    float mrun = -1e30f, lrun = 0.f;
    f32x16 p0, p1;
#pragma unroll
    for (int i = 0; i < 16; ++i) { p0[i] = 0.f; p1[i] = 0.f; }
    bf16x8 pf[2][2];
    if (w >= 4) asm volatile("s_barrier" ::: "memory");
#pragma unroll 1
    for (int it = 0; it <= nTot; ++it) {
        if (it + 1 < nTot) asm volatile("s_waitcnt vmcnt(4) lgkmcnt(0)\n\ts_barrier" ::: "memory"); else asm volatile("s_waitcnt vmcnt(0) lgkmcnt(0)\n\ts_barrier" ::: "memory");
        if (it > 0) { const int ti = it - 1;
            bool lane_on = true; bool edge = false; int klo = 0, khi = 63;
            if (ti < nS) { lane_on = ((selmask >> ti) & 1ull) != 0ull; if (ti == qb) { edge = true; khi = ql; } }
            else { const int j = jlo + ti - nS; if (j == qb) { edge = true; khi = ql; } if (j == qb - 8) { edge = true; klo = ql + 1; } }
            if (edge) {
#pragma unroll
                for (int i = 0; i < 16; ++i) { const int kl = (i & 3) + 8 * (i >> 2) + 4 * h; p0[i] = (kl >= klo && kl <= khi) ? p0[i] : NINF; p1[i] = (kl + 32 >= klo && kl + 32 <= khi) ? p1[i] : NINF; } }
            float tmx = nsa_rowmax(p0, p1); tmx = lane_on ? tmx : NINF; tmx = fmaxf(tmx, __shfl_xor(tmx, 32));
            float alpha = 1.f;
            if (__any((tmx - mrun) * SM_C > 8.f)) { const float mnew = fmaxf(mrun, tmx); alpha = __builtin_amdgcn_exp2f((mrun - mnew) * SM_C); mrun = mnew;
#pragma unroll
                for (int dt = 0; dt < 4; ++dt) o[dt] *= alpha; }
            const float nmc = lane_on ? -mrun * SM_C : NINF;
            float ls = 0.f;
#pragma unroll
            for (int i = 0; i < 16; ++i) { p0[i] = __builtin_amdgcn_exp2f(fmaf(p0[i], SM_C, nmc)); p1[i] = __builtin_amdgcn_exp2f(fmaf(p1[i], SM_C, nmc)); ls += p0[i] + p1[i]; }
            lrun = lrun * alpha + ls;
            pf[0][0] = nsa_pack8(p0, 0); pf[0][1] = nsa_pack8(p0, 1); pf[1][0] = nsa_pack8(p1, 0); pf[1][1] = nsa_pack8(p1, 1);
        }
        asm volatile("s_waitcnt lgkmcnt(0)\n\ts_barrier" ::: "memory");
        if (it + 2 < nTot) { const bf16 *kt, *vt; tile_src(it + 2, kt, vt); const int t2 = it + 2;
            int lo_ = lane; asm volatile("" : "+v"(lo_)); nsa_dma_tile(kt, PW * 2, vt, VTP * 2, ldsb + (t2 % 3) * NTB, ldsb + VOFF + (t2 & 3) * NTB, w, lo_); }
        int ro = r, ho = h; asm volatile("" : "+v"(ro), "+v"(ho));
        if (it > 0) { const int ti = it - 1;
            nsa_pv_sw(lds + VOFF + (ti & 3) * NTB, pf, o, ro, ho);
            if (ti == nS - 1 || ti == nTot - 1) {
                const float lt = lrun + __shfl_xor(lrun, 32); const float f = ((ti == nS - 1) ? g1 : g2) / lt;
#pragma unroll
                for (int dt = 0; dt < 4; ++dt) {
#pragma unroll
                    for (int aa = 0; aa < 4; ++aa) { const u32x2 pv = *(const GAS u32x2*)(mp + (32 * dt + 8 * aa) * 2); u32x2 wv;
                        wv.x = pg8::cvt_pk_bf16(bflo(pv.x) + o[dt][4 * aa] * f, bfhi(pv.x) + o[dt][4 * aa + 1] * f); wv.y = pg8::cvt_pk_bf16(bflo(pv.y) + o[dt][4 * aa + 2] * f, bfhi(pv.y) + o[dt][4 * aa + 3] * f);
                        *(GAS u32x2*)(mp + (32 * dt + 8 * aa) * 2) = wv; }
#pragma unroll
                    for (int i = 0; i < 16; ++i) o[dt][i] = 0.f; }
                mrun = -1e30f; lrun = 0.f;
                asm volatile("s_waitcnt vmcnt(0)" ::: "memory");
            }
        }
        if (it < nTot) nsa_qk_sw(lds + (it % 3) * NTB, qf, ro, ho, p0, p1);
    }
    if (w < 4) asm volatile("s_barrier" ::: "memory");
    __syncthreads();
#else
    u32x4 k0, k1, v0, v1;
    __syncthreads();
    nsa_ld2(ksb, offk, k0, k1); nsa_ld2(vsb, offv, v0, v1);
    nsa_st_k(lds, tid, k0, k1); nsa_st_v(lds + 2 * NBUF, tid, v0, v1);
    __syncthreads();
#pragma unroll
    for (int dt = 0; dt < 4; ++dt)
#pragma unroll
        for (int i = 0; i < 16; ++i) o[dt][i] = 0.f;
    float mrun = -1e30f, lrun = 0.f;
#pragma unroll 1
    for (int it = 0; it < nTot; ++it) {
        const LAS unsigned char* kbuf = lds + (it & 1) * NBUF; const LAS unsigned char* vbuf = lds + (2 + (it & 1)) * NBUF;
        const bf16* kn = ksb; const bf16* vn = vsb;
        if (it + 1 < nTot) { const int i2 = it + 1;
            if (i2 < nS) { kn = ksb + (size_t)(64 * i2) * PW; vn = vsb + 64 * i2; }
            else { const int j = jlo + i2 - nS; kn = kwb + (size_t)(64 * j) * PW; vn = vwb + 64 * j; }
            nsa_ld2(kn, offk, k0, k1); }
        f32x16 p0, p1;
        nsa_qk(kbuf, qf, r, h, p0, p1);
        if (it + 1 < nTot) { nsa_st_k(lds + ((it + 1) & 1) * NBUF, tid, k0, k1); nsa_ld2(vn, offv, v0, v1); }
        bool lane_on = true; bool edge = false; int klo = 0, khi = 63;
        if (it < nS) { lane_on = ((selmask >> it) & 1ull) != 0ull; if (it == qb) { edge = true; khi = ql; } }
        else { const int j = jlo + it - nS; if (j == qb) { edge = true; khi = ql; } if (j == qb - 8) { edge = true; klo = ql + 1; } }
        if (edge) {
#pragma unroll
            for (int i = 0; i < 16; ++i) { const int kl = (i & 3) + 8 * (i >> 2) + 4 * h; p0[i] = (kl >= klo && kl <= khi) ? p0[i] : NINF; p1[i] = (kl + 32 >= klo && kl + 32 <= khi) ? p1[i] : NINF; } }
        float tmx = nsa_rowmax(p0, p1); tmx = lane_on ? tmx : NINF; tmx = fmaxf(tmx, __shfl_xor(tmx, 32));
        const float mnew = fmaxf(mrun, tmx), alpha = __builtin_amdgcn_exp2f((mrun - mnew) * SM_C), nmc = lane_on ? -mnew * SM_C : NINF; mrun = mnew;
        float ls = 0.f;
#pragma unroll
        for (int i = 0; i < 16; ++i) { p0[i] = __builtin_amdgcn_exp2f(fmaf(p0[i], SM_C, nmc)); p1[i] = __builtin_amdgcn_exp2f(fmaf(p1[i], SM_C, nmc)); ls += p0[i] + p1[i]; }
        lrun = lrun * alpha + ls;
        if (__any(alpha != 1.f)) {
#pragma unroll
            for (int dt = 0; dt < 4; ++dt) o[dt] *= alpha; }
        { bf16x8 pf[2][2]; pf[0][0] = nsa_pack8(p0, 0); pf[0][1] = nsa_pack8(p0, 1); pf[1][0] = nsa_pack8(p1, 0); pf[1][1] = nsa_pack8(p1, 1); nsa_pv(vbuf, pf, o, r, h); }
        if (it == nS - 1 || it == nTot - 1) {
            const float lt = lrun + __shfl_xor(lrun, 32); const float f = ((it == nS - 1) ? g1 : g2) / lt;
#pragma unroll
            for (int dt = 0; dt < 4; ++dt) {
#pragma unroll
                for (int aa = 0; aa < 4; ++aa) { const u32x2 pv = *(const GAS u32x2*)(mp + (32 * dt + 8 * aa) * 2); u32x2 wv;
                    wv.x = pg8::cvt_pk_bf16(bflo(pv.x) + o[dt][4 * aa] * f, bfhi(pv.x) + o[dt][4 * aa + 1] * f); wv.y = pg8::cvt_pk_bf16(bflo(pv.y) + o[dt][4 * aa + 2] * f, bfhi(pv.y) + o[dt][4 * aa + 3] * f);
                    *(GAS u32x2*)(mp + (32 * dt + 8 * aa) * 2) = wv; }
#pragma unroll
                for (int i = 0; i < 16; ++i) o[dt][i] = 0.f; }
            mrun = -1e30f; lrun = 0.f;
        }
        if (it + 1 < nTot) nsa_st_v(lds + (2 + ((it + 1) & 1)) * NBUF, tid, v0, v1);
        __syncthreads();
    }
#endif
}
__device__ __forceinline__ void p_nsa_f(const Args& a, LAS unsigned char* lds) {
    for (int u = blockIdx.x; u < 256; u += gridDim.x) { const int bk = u & 7, pr = u >> 3;
#pragma unroll 1
        for (int rep = 0; rep < 2; ++rep) nsa_unit(a, lds, bk >> 1, bk & 1, rep ? pr : 63 - pr); }
}
__device__ __forceinline__ void p_vtrans(const Args& a, LAS unsigned char* lds) {
    const int tid = threadIdx.x; const bf16* proj = (const bf16*)(a.ws + WS_PROJ);
    LAS bf16* sm = (LAS bf16*)lds;
    for (int it = blockIdx.x; it < 2 * 8 * 64; it += gridDim.x) {
        const int ts = it >> 9, bk = (it >> 6) & 7, kt = it & 63, b = bk >> 1, kvh = bk & 1;
        const bf16* src = proj + ((size_t)b * T + 64 * kt) * PW + (ts ? PVW : PVS) + kvh * 128;
        bf16* dst = (bf16*)(a.ws + (ts ? WS_VTW : WS_VTS)) + (size_t)(bk * 128) * VTP + 64 * kt;
        __syncthreads();
        { const int key = tid >> 3, ch = tid & 7; const bf16* p = src + (size_t)key * PW + ch * 16; const u32x4 x0 = *(const u32x4*)p, x1 = *(const u32x4*)(p + 8);
          LAS u32x4* q = (LAS u32x4*)(sm + key * 136 + ch * 16); q[0] = x0; q[1] = x1; }
        __syncthreads();
#pragma unroll
        for (int rep = 0; rep < 2; ++rep) { const int cidx = tid + rep * 512, d = cidx >> 3, kc = cidx & 7;
            unsigned short e[8];
#pragma unroll
            for (int i = 0; i < 8; ++i) e[i] = sm[(16 * (kc >> 1) + 4 * (kc & 1) + 8 * (i >> 2) + (i & 3)) * 136 + d];
            u32x4 wv; wv.x = e[0] | ((unsigned)e[1] << 16); wv.y = e[2] | ((unsigned)e[3] << 16); wv.z = e[4] | ((unsigned)e[5] << 16); wv.w = e[6] | ((unsigned)e[7] << 16);
            *(u32x4*)(dst + (size_t)d * VTP + kc * 8) = wv; }
    }
}


__device__ __forceinline__ void p0_cmp_weights(const Args& a, LAS unsigned char* lds) {
    const int lane = threadIdx.x & 63, wave = __builtin_amdgcn_readfirstlane(threadIdx.x >> 6), tid = threadIdx.x;
    LAS float* scr = (LAS float*)(lds + 65536 + wave * 8704);
    const int gw = blockIdx.x * 8 + wave, NGW = gridDim.x * 8;
    auto rm_id = [](int n) { return n; };
    bf16* W1T = (bf16*)(a.ws + WS_CW1T); bf16* W2T = (bf16*)(a.ws + WS_CW2T);
    for (int it = gw; it < 4 * 256 + 4 * 8; it += NGW) {
        if (it < 1024) { const int lk = it >> 8, r = it & 255, l = lk >> 1, kind = lk & 1;
            transpose_item(a.in[kind ? I_CW1V : I_CW1K] + (size_t)l * 4096 * 256, 4096, 256, W1T + (size_t)lk * 256 * VTP, scr, r, lane, rm_id, VTP); }
        else { const int r2 = it - 1024, lk = r2 >> 3, r = r2 & 7, l = lk >> 1, kind = lk & 1;
            transpose_item(a.in[kind ? I_CW2V : I_CW2K] + (size_t)l * 256 * 128, 256, 128, W2T + (size_t)lk * 128 * 256, scr, r, lane, rm_id); }
    }
    float* cpart = (float*)(a.ws + WS_CPART);
    LAS float* red = (LAS float*)lds;
    for (int it = blockIdx.x; it < 128; it += gridDim.x) {
        const int lk = it >> 5, sl = it & 31, l = lk >> 1, kind = lk & 1, n = tid & 255, kh = tid >> 8;
        const float* pe = a.in[kind ? I_CPV : I_CPK] + (size_t)l * 4096; const float* w1 = a.in[kind ? I_CW1V : I_CW1K] + (size_t)l * 4096 * 256;
        float s = 0.f;
#pragma unroll 8
        for (int kk = 0; kk < 64; ++kk) { const int k = sl * 128 + kh * 64 + kk; s += pe[k] * w1[(size_t)k * 256 + n]; }
        __syncthreads(); red[tid] = s; __syncthreads();
        if (tid < 256) cpart[(lk * 32 + sl) * 256 + tid] = red[tid] + red[tid + 256];
    }
}
template <int L> __device__ __forceinline__ void p_cmp1_f(const Args& a, LAS unsigned char* lds) {
    const int lane = threadIdx.x & 63, wave = __builtin_amdgcn_readfirstlane(threadIdx.x >> 6), r = lane & 31, hh = lane >> 5;
    const gcp projU = uniform_ptr(a.ws + WS_PROJ);
    LAS float* red = (LAS float*)lds;
    for (int u = blockIdx.x; u < 256; u += gridDim.x) {
        const int kind = u >> 7, rt = (u >> 2) & 31, nt = u & 3, lk = L * 2 + kind;
        unsigned aoff[2], woff[2];
#pragma unroll
        for (int h2 = 0; h2 < 2; ++h2) { const int row = rt * 64 + h2 * 32 + r, bh = row >> 8, c = row & 255, cc = c < 255 ? c : 254;
            aoff[h2] = (unsigned)((((bh >> 1) * T + 16 * cc) * PW + (kind ? PVC : PKC) + (bh & 1) * 128 + 8 * hh) * 2);
            woff[h2] = (unsigned)(((64 * nt + 32 * h2 + r) * VTP + 8 * hh) * 2); }
        const gcp w1U = uniform_ptr((const bf16*)(a.ws + WS_CW1T) + (size_t)lk * 256 * VTP);
        f32x16 acc[2][2];
        { const float* cpart = (const float*)(a.ws + WS_CPART) + (size_t)lk * 32 * 256 + (size_t)(4 * wave) * 256;
#pragma unroll
          for (int ch = 0; ch < 2; ++ch)
#pragma unroll
              for (int aa = 0; aa < 4; ++aa) { const int n0 = 64 * nt + 32 * ch + 8 * aa + 4 * hh;
                  const f32x4 bs = (*(const f32x4*)(cpart + n0) + *(const f32x4*)(cpart + 256 + n0)) + (*(const f32x4*)(cpart + 512 + n0) + *(const f32x4*)(cpart + 768 + n0));
#pragma unroll
                  for (int i = 0; i < 4; ++i) { acc[0][ch][4 * aa + i] = bs[i]; acc[1][ch][4 * aa + i] = bs[i]; } } }
#pragma unroll 1
        for (int lb = 0; lb < 4; ++lb) {
            const unsigned la = (unsigned)((4 * wave + lb) * PW * 2), lw = (unsigned)((4 * wave + lb) * 128 * 2);
            bf16x8 bqv[8][2], a0v[8][2];
#pragma unroll
            for (int kk = 0; kk < 8; ++kk)
#pragma unroll
                for (int h2 = 0; h2 < 2; ++h2) { bqv[kk][h2] = gld<bf16x8>(projU + (aoff[h2] + la + (unsigned)(kk * 32))); a0v[kk][h2] = gld<bf16x8>(w1U + (woff[h2] + lw + (unsigned)(kk * 32))); }
            __builtin_amdgcn_sched_barrier(0);
#pragma unroll
            for (int kk = 0; kk < 8; ++kk)
#pragma unroll
                for (int rh = 0; rh < 2; ++rh)
#pragma unroll
                    for (int ch = 0; ch < 2; ++ch) acc[rh][ch] = __builtin_amdgcn_mfma_f32_32x32x16_bf16(a0v[kk][ch], bqv[kk][rh], acc[rh][ch], 0, 0, 0);
            __builtin_amdgcn_sched_barrier(0);
        }
#define CMP1_DUMP(slot, rh) do { _Pragma("unroll") for (int ch = 0; ch < 2; ++ch) _Pragma("unroll") for (int i = 0; i < 16; ++i) red[(((slot) * 4 + (rh) * 2 + ch) * 16 + i) * 64 + lane] = acc[rh][ch][i]; } while (0)
#define CMP1_ADD(slot, rh) do { _Pragma("unroll") for (int ch = 0; ch < 2; ++ch) _Pragma("unroll") for (int i = 0; i < 16; ++i) acc[rh][ch][i] += red[(((slot) * 4 + (rh) * 2 + ch) * 16 + i) * 64 + lane]; } while (0)
        __syncthreads();
        if (wave >= 4) { CMP1_DUMP(wave - 4, 0); CMP1_DUMP(wave - 4, 1); }
        __syncthreads();
        if (wave < 4) { CMP1_ADD(wave, 0); CMP1_ADD(wave, 1); }
        if (wave == 2 || wave == 3) { CMP1_DUMP(wave, 0); CMP1_DUMP(wave, 1); }
        __syncthreads();
        if (wave < 2) { CMP1_ADD(wave + 2, 0); CMP1_ADD(wave + 2, 1); }
        if (wave == 0) CMP1_DUMP(0, 1);
        if (wave == 1) CMP1_DUMP(1, 0);
        __syncthreads();
        if (wave < 2) {
            if (wave == 0) CMP1_ADD(1, 0); else CMP1_ADD(0, 1);
            const int row = rt * 64 + wave * 32 + r, c = row & 255;
            bf16* hid = (bf16*)(a.ws + WS_CHIDB) + ((size_t)kind * NCR + row) * 256 + 64 * nt + 4 * hh;
#pragma unroll
            for (int ch = 0; ch < 2; ++ch)
#pragma unroll
                for (int aa = 0; aa < 4; ++aa) { float o4[4];
#pragma unroll
                    for (int i = 0; i < 4; ++i) { const float v = wave == 0 ? acc[0][ch][4 * aa + i] : acc[1][ch][4 * aa + i]; o4[i] = c < 255 ? gelu_tanh(v) : 0.f; }
                    u32x2 wv; wv.x = pg8::cvt_pk_bf16(o4[0], o4[1]); wv.y = pg8::cvt_pk_bf16(o4[2], o4[3]); *(u32x2*)(hid + 32 * ch + 8 * aa) = wv; }
        }
        __syncthreads();
#undef CMP1_DUMP
#undef CMP1_ADD
    }
}
template <int L> __device__ __forceinline__ void p_cmp2_f(const Args& a) {
    const int lane = threadIdx.x & 63, wave = __builtin_amdgcn_readfirstlane(threadIdx.x >> 6), r = lane & 31, hh = lane >> 5;
    const int gw = wave * gridDim.x + blockIdx.x, NGW = gridDim.x * 8;
    float* KC = (float*)(a.ws + WS_KC); bf16* KCB = (bf16*)(a.ws + WS_KCB); bf16* VCT = (bf16*)(a.ws + WS_VCT);
    for (int u = gw; u < 128; u += NGW) {
        const int kind = u >> 6, rt = u & 63, lk = L * 2 + kind, row = rt * 32 + r;
        const bf16* hp = (const bf16*)(a.ws + WS_CHIDB) + ((size_t)kind * NCR + row) * 256 + 8 * hh;
        const bf16* w2 = (const bf16*)(a.ws + WS_CW2T) + (size_t)lk * 128 * 256 + (size_t)r * 256 + 8 * hh;
        f32x16 acc[4];
#pragma unroll
        for (int dt = 0; dt < 4; ++dt)
#pragma unroll
            for (int i = 0; i < 16; ++i) acc[dt][i] = 0.f;
#pragma unroll 1
        for (int kq = 0; kq < 4; ++kq) { bf16x8 bqv[4], afv[4][4];
#pragma unroll
            for (int k4 = 0; k4 < 4; ++k4) { const int ks = 4 * kq + k4; bqv[k4] = *(const bf16x8*)(hp + 16 * ks);
#pragma unroll
                for (int dt = 0; dt < 4; ++dt) afv[k4][dt] = *(const bf16x8*)(w2 + (size_t)dt * 32 * 256 + 16 * ks); }
            __builtin_amdgcn_sched_barrier(0);
#pragma unroll
            for (int k4 = 0; k4 < 4; ++k4)
#pragma unroll
                for (int dt = 0; dt < 4; ++dt) acc[dt] = __builtin_amdgcn_mfma_f32_32x32x16_bf16(afv[k4][dt], bqv[k4], acc[dt], 0, 0, 0);
            __builtin_amdgcn_sched_barrier(0); }
#pragma unroll
        for (int dt = 0; dt < 4; ++dt)
#pragma unroll
            for (int aa = 0; aa < 4; ++aa) { const int d0 = 32 * dt + 8 * aa + 4 * hh; const f32x4 v = (f32x4){acc[dt][4 * aa], acc[dt][4 * aa + 1], acc[dt][4 * aa + 2], acc[dt][4 * aa + 3]};
                *(f32x4*)(KC + ((size_t)kind * NCR + row) * 128 + d0) = v;
                if (kind == 0) st_bf4(KCB + (size_t)row * 128 + d0, v);
                else { const int cpos = (row & 240) + vperm16(row & 15); bf16* vp = VCT + (size_t)((row >> 8) * 128 + d0) * 256 + cpos; vp[0] = (bf16)f2bf(v.x); vp[256] = (bf16)f2bf(v.y); vp[512] = (bf16)f2bf(v.z); vp[768] = (bf16)f2bf(v.w); } }
    }
}
template <int L, bool WITH_LA> __device__ __forceinline__ void p_rope_la(const Args& a) {
    bf16* proj = (bf16*)(a.ws + WS_PROJ);
    const float* rope = (const float*)(a.ws + WS_ROPE);
    const int gt = blockIdx.x * 512 + threadIdx.x, NGT = gridDim.x * 512;
    for (int idx = gt; idx < M * 64; idx += NGT) {
        const int i = idx & 15, hh = (idx >> 4) & 1, ts = (idx >> 5) & 1, m = idx >> 6, t = m & (T - 1);
        bf16* p = proj + (size_t)m * PW + (ts ? PKW : PKS) + hh * 128 + i;
        const float x1 = bf1(p[0]), x2 = bf1(p[16]), c = rope[t * 32 + i], s = rope[t * 32 + 16 + i];
        p[0] = (bf16)f2bf(x1 * c - x2 * s); p[16] = (bf16)f2bf(x2 * c + x1 * s);
    }
    float* LA = (float*)(a.ws + WS_LA);
    const float* wa2 = a.in[I_GWA2] + (size_t)L * 16 * 512; const float* ba = a.in[I_GBA] + (size_t)L * 512;
    if (WITH_LA)
    for (int idx = gt; idx < M * 512; idx += NGT) {
        const int hd = idx & 511, m = idx >> 9; const bf16* ga = proj + (size_t)m * PW + PGA;
        float z = ba[hd];
#pragma unroll
        for (int r = 0; r < 16; ++r) z += bf1(ga[r]) * wa2[r * 512 + hd];
        const float ls = fminf(z, 0.f) - log1pf(__expf(-fabsf(z)));
        LA[idx] = ls * (1.f / 16.f);
    }
}


constexpr size_t WS_HS = 484 * MiB;
constexpr size_t WS_SSB = WS_GLAO;
constexpr size_t WS_DEC = 11 * MiB;
static_assert(WS_HS + (size_t)16 * 64 * 256 * 128 * 4 <= WS_HPERM, "HS inside the free overlay");
constexpr int G_QROW = 136, G_VROW = 264;
__device__ __forceinline__ bf16x8 lds_gather8(const LAS bf16* p, int stride) {
    const unsigned e0 = p[0], e1 = p[stride], e2 = p[2 * stride], e3 = p[3 * stride], e4 = p[4 * stride], e5 = p[5 * stride], e6 = p[6 * stride], e7 = p[7 * stride];
    u32x4 w; w.x = e0 | (e1 << 16); w.y = e2 | (e3 << 16); w.z = e4 | (e5 << 16); w.w = e6 | (e7 << 16); return __builtin_bit_cast(bf16x8, w);
}
__device__ __forceinline__ void gla_stage_v(gcp projU, unsigned rowoff0, int h, LAS bf16* VS, int tid) {
    const int j = tid >> 3, ch = tid & 7;
    const gcp p = projU + (rowoff0 + (unsigned)((j * PW + PGV + h * 256 + ch * 32) * 2));
    const u32x4 x0 = gld<u32x4>(p), x1 = gld<u32x4>(p + 16), x2 = gld<u32x4>(p + 32), x3 = gld<u32x4>(p + 48);
    LAS u32x4* q = (LAS u32x4*)(VS + j * G_VROW + ch * 32); q[0] = x0; q[1] = x1; q[2] = x2; q[3] = x3;
}
template <int L> __device__ __forceinline__ void p_gla1(const Args& a, LAS unsigned char* lds) {
    const int tid = threadIdx.x, lane = tid & 63, w = __builtin_amdgcn_readfirstlane(tid >> 6), r = lane & 31, hh = lane >> 5;
    LAS bf16* KS = (LAS bf16*)lds; LAS bf16* VS = (LAS bf16*)(lds + 18432); LAS float* qt = (LAS float*)(lds + 18432 + 33792); LAS u32x4* GIN = (LAS u32x4*)(lds + 18432 + 33792 + 2048);
    const gcp projU = uniform_ptr(a.ws + WS_PROJ);
    float* BC = (float*)(a.ws + WS_LA); bf16* HS = (bf16*)(a.ws + WS_HS); float* DEC = (float*)(a.ws + WS_DEC);
    const float* wa2 = a.in[I_GWA2] + (size_t)L * 16 * 512; const float* ba = a.in[I_GBA] + (size_t)L * 512;
    const int d = tid & 127, jq = tid >> 7;
    u32x4 pv[4], pga; unsigned short pk[16];
    auto issue = [&](int u) {
        const int bh = u >> 6, c = u & 63, b = bh >> 2, h = bh & 3, m0 = b * T + c * 64;
        const unsigned rowoff0 = (unsigned)m0 * (unsigned)(PW * 2);
        { const int j = tid >> 3, ch = tid & 7; const gcp p = projU + (rowoff0 + (unsigned)((j * PW + PGV + h * 256 + ch * 32) * 2));
          pv[0] = gld<u32x4>(p); pv[1] = gld<u32x4>(p + 16); pv[2] = gld<u32x4>(p + 32); pv[3] = gld<u32x4>(p + 48); }
        pga = gld<u32x4>(projU + (rowoff0 + (unsigned)((((tid & 127) >> 1) * PW + PGA) * 2 + (tid & 1) * 16)));
#pragma unroll
        for (int i = 0; i < 16; ++i) pk[i] = gld<bf16>(projU + (rowoff0 + (unsigned)(((jq * 16 + i) * PW + PGK + h * 128 + d) * 2)));
    };
    int hprev = -1; float wv[16]; float bias = 0.f;
    if ((int)blockIdx.x < 1024) issue(blockIdx.x);
    for (int u = blockIdx.x; u < 1024; u += gridDim.x) {
        const int bh = u >> 6, c = u & 63, b = bh >> 2, h = bh & 3, m0 = b * T + c * 64;
        if (h != hprev) { hprev = h;
#pragma unroll
            for (int rr = 0; rr < 16; ++rr) wv[rr] = wa2[rr * 512 + h * 128 + d];
            bias = ba[h * 128 + d]; }
        __syncthreads();
        { const int j = tid >> 3, ch = tid & 7; LAS u32x4* q = (LAS u32x4*)(VS + j * G_VROW + ch * 32); q[0] = pv[0]; q[1] = pv[1]; q[2] = pv[2]; q[3] = pv[3]; }
        if (tid < 128) GIN[tid] = pga;
        float kraw[16];
#pragma unroll
        for (int i = 0; i < 16; ++i) kraw[i] = bf1(pk[i]);
        __syncthreads();
        { float pre[16]; float run = 0.f;
#pragma unroll
          for (int i = 0; i < 16; ++i) { const u32x4 g0 = GIN[(jq * 16 + i) * 2], g1 = GIN[(jq * 16 + i) * 2 + 1];
              float z = bias + bflo(g0.x) * wv[0] + bfhi(g0.x) * wv[1] + bflo(g0.y) * wv[2] + bfhi(g0.y) * wv[3] + bflo(g0.z) * wv[4] + bfhi(g0.z) * wv[5] + bflo(g0.w) * wv[6] + bfhi(g0.w) * wv[7]
                      + bflo(g1.x) * wv[8] + bfhi(g1.x) * wv[9] + bflo(g1.y) * wv[10] + bfhi(g1.y) * wv[11] + bflo(g1.z) * wv[12] + bfhi(g1.z) * wv[13] + bflo(g1.w) * wv[14] + bfhi(g1.w) * wv[15];
              const float la = (fminf(z, 0.f) - __logf(1.f + __expf(-fabsf(z)))) * (1.f / 16.f); run += la; pre[i] = run; }
          qt[jq * 128 + d] = run;
          __syncthreads();
          float off = 0.f, tot = 0.f;
#pragma unroll
          for (int q = 0; q < 4; ++q) { const float v = qt[q * 128 + d]; off += (q < jq) ? v : 0.f; tot += v; }
          float ksv[16];
#pragma unroll
          for (int i = 0; i < 16; ++i) { const int j = jq * 16 + i; const float bj = off + pre[i];
              BC[(size_t)(m0 + j) * 512 + h * 128 + d] = bj;
              ksv[i] = kraw[i] * __expf(tot - bj); }
          { u32x4 w0, w1; w0.x = pk2(ksv[0], ksv[1]); w0.y = pk2(ksv[2], ksv[3]); w0.z = pk2(ksv[4], ksv[5]); w0.w = pk2(ksv[6], ksv[7]); w1.x = pk2(ksv[8], ksv[9]); w1.y = pk2(ksv[10], ksv[11]); w1.z = pk2(ksv[12], ksv[13]); w1.w = pk2(ksv[14], ksv[15]);
            LAS u32x4* kq = (LAS u32x4*)(KS + d * 72 + jq * 16); kq[0] = w0; kq[1] = w1; }
          if (jq == 0) DEC[(size_t)(bh * 64 + c) * 128 + d] = __expf(tot); }
        __syncthreads();
        if (u + (int)gridDim.x < 1024) issue(u + gridDim.x);
        __builtin_amdgcn_sched_barrier(0);
        f32x16 acc[4];
#pragma unroll
        for (int dt = 0; dt < 4; ++dt)
#pragma unroll
            for (int i = 0; i < 16; ++i) acc[dt][i] = 0.f;
#pragma unroll
        for (int ks = 0; ks < 4; ++ks) { const bf16x8 bq = lds_gather8(VS + (16 * ks + 8 * hh) * G_VROW + 32 * w + r, G_VROW); bf16x8 afv[4];
#pragma unroll
            for (int dt = 0; dt < 4; ++dt) afv[dt] = *(const LAS bf16x8*)(KS + (32 * dt + r) * 72 + 16 * ks + 8 * hh);
            __builtin_amdgcn_sched_barrier(0);
#pragma unroll
            for (int dt = 0; dt < 4; ++dt) acc[dt] = __builtin_amdgcn_mfma_f32_32x32x16_bf16(afv[dt], bq, acc[dt], 0, 0, 0);
            __builtin_amdgcn_sched_barrier(0); }
        bf16* hp = HS + ((size_t)(bh * 64 + c) * 256 + 32 * w + r) * 128 + 4 * hh;
#pragma unroll
        for (int dt = 0; dt < 4; ++dt)
#pragma unroll
            for (int aa = 0; aa < 4; ++aa) st_bf4(hp + 32 * dt + 8 * aa, (f32x4){acc[dt][4 * aa], acc[dt][4 * aa + 1], acc[dt][4 * aa + 2], acc[dt][4 * aa + 3]});
    }
}
__device__ __forceinline__ void p_gla2(const Args& a) {
    const bf16* HS = (const bf16*)(a.ws + WS_HS); const float* DEC = (const float*)(a.ws + WS_DEC); bf16* SSB = (bf16*)(a.ws + WS_SSB);
    for (int idx = blockIdx.x * 512 + threadIdx.x; idx < 16 * 256 * 32; idx += gridDim.x * 512) {
        const int bh = idx >> 13, e = (idx >> 5) & 255, d4 = idx & 31;
        f32x4 S = (f32x4){0.f, 0.f, 0.f, 0.f};
        u32x2 hA[8], hB[8]; f32x4 dA[8], dB[8];
#define GLA2_LD(H, Dc, C0) do { _Pragma("unroll") for (int i = 0; i < 8; ++i) { H[i] = *(const u32x2*)(HS + ((size_t)(bh * 64 + (C0) + i) * 256 + e) * 128 + d4 * 4); Dc[i] = *(const f32x4*)(DEC + (size_t)(bh * 64 + (C0) + i) * 128 + d4 * 4); } } while (0)
#define GLA2_ST(H, Dc, C0) do { _Pragma("unroll") for (int i = 0; i < 8; ++i) { st_bf4(SSB + ((size_t)(bh * 64 + (C0) + i) * 256 + e) * 128 + d4 * 4, S); S = S * Dc[i] + (f32x4){bflo(H[i].x), bfhi(H[i].x), bflo(H[i].y), bfhi(H[i].y)}; } } while (0)
        GLA2_LD(hA, dA, 0);
#pragma unroll 1
        for (int c0 = 0; c0 < 64; c0 += 16) {
            GLA2_LD(hB, dB, c0 + 8); __builtin_amdgcn_sched_barrier(0);
            GLA2_ST(hA, dA, c0); __builtin_amdgcn_sched_barrier(0);
            if (c0 + 16 < 64) GLA2_LD(hA, dA, c0 + 16);
            __builtin_amdgcn_sched_barrier(0);
            GLA2_ST(hB, dB, c0 + 8); __builtin_amdgcn_sched_barrier(0);
        }
#undef GLA2_LD
#undef GLA2_ST
    }
}
template <int L> __device__ __forceinline__ void p_gla3(const Args& a, LAS unsigned char* lds) {
    const int tid = threadIdx.x, lane = tid & 63, w = __builtin_amdgcn_readfirstlane(tid >> 6), r = lane & 31, hh = lane >> 5;
    LAS bf16* QD = (LAS bf16*)lds; LAS bf16* KI = (LAS bf16*)(lds + 17408); LAS bf16* VS = (LAS bf16*)(lds + 34816); LAS float* part = (LAS float*)(lds + 34816 + 33792);
    const gcp projU = uniform_ptr(a.ws + WS_PROJ);
    const float* BC = (const float*)(a.ws + WS_LA); const bf16* SSB = (const bf16*)(a.ws + WS_SSB); bf16* mix = (bf16*)(a.ws + WS_MIX);
    const float* nw = a.in[I_GNW] + (size_t)L * 256;
    const int ih = w & 1;
    for (int u = blockIdx.x; u < 1024; u += gridDim.x) {
        const int bh = u >> 6, c = u & 63, b = bh >> 2, h = bh & 3, m0 = b * T + c * 64;
        const unsigned rowoff0 = (unsigned)m0 * (unsigned)(PW * 2);
        __syncthreads();
        bf16x8 sfr[2][8];
        { const int j = tid >> 3, dg = tid & 7, ch = tid & 7;
          const gcp vp0 = projU + (rowoff0 + (unsigned)((j * PW + PGV + h * 256 + ch * 32) * 2));
          const u32x4 x0 = gld<u32x4>(vp0), x1 = gld<u32x4>(vp0 + 16), x2 = gld<u32x4>(vp0 + 32), x3 = gld<u32x4>(vp0 + 48);
          const gcp qp = projU + (rowoff0 + (unsigned)((j * PW + PGQ + h * 128 + dg * 16) * 2)); const gcp kp = projU + (rowoff0 + (unsigned)((j * PW + PGK + h * 128 + dg * 16) * 2));
          const float* bp = BC + (size_t)(m0 + j) * 512 + h * 128 + dg * 16;
          u32x4 qrv[2], krv[2]; f32x4 b0v[2], b1v[2];
#pragma unroll
          for (int hf = 0; hf < 2; ++hf) { qrv[hf] = gld<u32x4>(qp + 16 * hf); krv[hf] = gld<u32x4>(kp + 16 * hf); b0v[hf] = *(const f32x4*)(bp + 8 * hf); b1v[hf] = *(const f32x4*)(bp + 8 * hf + 4); }
#pragma unroll
          for (int t2 = 0; t2 < 2; ++t2) { const bf16* sp = SSB + ((size_t)(bh * 64 + c) * 256 + 32 * ((w >> 1) * 2 + t2) + r) * 128 + 8 * hh;
#pragma unroll
              for (int ks = 0; ks < 8; ++ks) sfr[t2][ks] = *(const bf16x8*)(sp + 16 * ks); }
          __builtin_amdgcn_sched_barrier(0);
          { LAS u32x4* q = (LAS u32x4*)(VS + j * G_VROW + ch * 32); q[0] = x0; q[1] = x1; q[2] = x2; q[3] = x3; }
          u32x4 qo[2], ko[2];
#pragma unroll
          for (int hf = 0; hf < 2; ++hf) { const u32x4 qr = qrv[hf], kr = krv[hf]; const f32x4 b0 = b0v[hf], b1 = b1v[hf];
              const float bv[8] = {b0.x, b0.y, b0.z, b0.w, b1.x, b1.y, b1.z, b1.w};
#pragma unroll
              for (int i = 0; i < 4; ++i) { const float e0 = __expf(bv[2 * i]), e1 = __expf(bv[2 * i + 1]);
                  qo[hf][i] = pg8::cvt_pk_bf16(bflo(qr[i]) * QSCALE * e0, bfhi(qr[i]) * QSCALE * e1); ko[hf][i] = pg8::cvt_pk_bf16(bflo(kr[i]) * __builtin_amdgcn_rcpf(e0), bfhi(kr[i]) * __builtin_amdgcn_rcpf(e1)); } }
          LAS u32x4* qd = (LAS u32x4*)(QD + j * G_QROW + dg * 16); qd[0] = qo[0]; qd[1] = qo[1];
          LAS u32x4* kd = (LAS u32x4*)(KI + j * G_QROW + dg * 16); kd[0] = ko[0]; kd[1] = ko[1]; }
        __syncthreads();
        const int mi = m0 + 32 * ih + r;
        u32x2 ggv[2][4]; f32x4 w4v[2][4];
#pragma unroll
        for (int t2 = 0; t2 < 2; ++t2)
#pragma unroll
            for (int aa = 0; aa < 4; ++aa) { const int e0 = 32 * ((w >> 1) * 2 + t2) + 8 * aa + 4 * hh; ggv[t2][aa] = gld<u32x2>(projU + ((unsigned)mi * (unsigned)(PW * 2) + (unsigned)((PGG + h * 256 + e0) * 2))); w4v[t2][aa] = *(const f32x4*)(nw + e0); }
        __builtin_amdgcn_sched_barrier(0);
        bf16x8 qdf[8];
#pragma unroll
        for (int ks = 0; ks < 8; ++ks) qdf[ks] = *(const LAS bf16x8*)(QD + (32 * ih + r) * G_QROW + 16 * ks + 8 * hh);
        bf16x8 pf[2][2];
#pragma unroll
        for (int jh = 0; jh < 2; ++jh) { f32x16 X;
#pragma unroll
            for (int i = 0; i < 16; ++i) X[i] = 0.f;
            if (jh <= ih) {
#pragma unroll
                for (int kq = 0; kq < 2; ++kq) { bf16x8 afx[4];
#pragma unroll
                    for (int k4 = 0; k4 < 4; ++k4) afx[k4] = *(const LAS bf16x8*)(KI + (32 * jh + r) * G_QROW + 16 * (4 * kq + k4) + 8 * hh);
                    __builtin_amdgcn_sched_barrier(0);
#pragma unroll
                    for (int k4 = 0; k4 < 4; ++k4) X = __builtin_amdgcn_mfma_f32_32x32x16_bf16(afx[k4], qdf[4 * kq + k4], X, 0, 0, 0);
                    __builtin_amdgcn_sched_barrier(0); }
#pragma unroll
                for (int i = 0; i < 16; ++i) { const int jj = 32 * jh + (i & 3) + 8 * (i >> 2) + 4 * hh; X[i] = (jj <= 32 * ih + r) ? X[i] : 0.f; } }
            pf[jh][0] = nsa_pack8(X, 0); pf[jh][1] = nsa_pack8(X, 1); }
        f32x16 o2[2];
#pragma unroll
        for (int t2 = 0; t2 < 2; ++t2) { const int et = (w >> 1) * 2 + t2;
#pragma unroll
            for (int i = 0; i < 16; ++i) o2[t2][i] = 0.f;
#pragma unroll
            for (int jh = 0; jh < 2; ++jh) if (jh <= ih) {
#pragma unroll
                for (int ss = 0; ss < 2; ++ss) { const LAS bf16* vp = VS + (32 * jh + 16 * ss + 4 * hh) * G_VROW + 32 * et + r;
                    const unsigned e0 = vp[0], e1 = vp[G_VROW], e2 = vp[2 * G_VROW], e3 = vp[3 * G_VROW], e4 = vp[8 * G_VROW], e5 = vp[9 * G_VROW], e6 = vp[10 * G_VROW], e7 = vp[11 * G_VROW];
                    u32x4 wv; wv.x = e0 | (e1 << 16); wv.y = e2 | (e3 << 16); wv.z = e4 | (e5 << 16); wv.w = e6 | (e7 << 16);
                    o2[t2] = __builtin_amdgcn_mfma_f32_32x32x16_bf16(__builtin_bit_cast(bf16x8, wv), pf[jh][ss], o2[t2], 0, 0, 0); } }
#pragma unroll
            for (int ks = 0; ks < 8; ++ks) o2[t2] = __builtin_amdgcn_mfma_f32_32x32x16_bf16(sfr[t2][ks], qdf[ks], o2[t2], 0, 0, 0);
            __builtin_amdgcn_sched_barrier(0); }
        float ss = 0.f;
#pragma unroll
        for (int t2 = 0; t2 < 2; ++t2)
#pragma unroll
            for (int i = 0; i < 16; ++i) ss += o2[t2][i] * o2[t2][i];
        ss += __shfl_xor(ss, 32);
        if (hh == 0) part[(w >> 1) * 64 + 32 * ih + r] = ss;
        __syncthreads();
        const float tot = (part[32 * ih + r] + part[64 + 32 * ih + r]) + (part[128 + 32 * ih + r] + part[192 + 32 * ih + r]);
        const float rinv = 1.f / sqrtf(tot * (1.f / 256.f) + NORM_EPS);
#pragma unroll
        for (int t2 = 0; t2 < 2; ++t2) { const int et = (w >> 1) * 2 + t2;
#pragma unroll
            for (int aa = 0; aa < 4; ++aa) { const int e0 = 32 * et + 8 * aa + 4 * hh;
                const u32x2 ggw = ggv[t2][aa]; const f32x4 gg = (f32x4){bflo(ggw.x), bfhi(ggw.x), bflo(ggw.y), bfhi(ggw.y)}; const f32x4 w4 = w4v[t2][aa];
                f32x4 y; y.x = o2[t2][4 * aa] * rinv * w4.x * siluf_(gg.x); y.y = o2[t2][4 * aa + 1] * rinv * w4.y * siluf_(gg.y); y.z = o2[t2][4 * aa + 2] * rinv * w4.z * siluf_(gg.z); y.w = o2[t2][4 * aa + 3] * rinv * w4.w * siluf_(gg.w);
                st_bf4(mix + (size_t)mi * 2048 + 1024 + h * 256 + e0, y); } }
    }
}

template <int L> __device__ __forceinline__ void p_inproj_f(const Args& a, LAS unsigned char* lds) {
    pg8::Gemm g{(const bf16*)(a.ws + WS_HB), (const bf16*)(a.ws + WS_WIN_T) + (size_t)L * PW * D, M, PW, D}; pg8::StaticOrder S; S.init(M, PW, gridDim.x, blockIdx.x);
    EpiStoreBf16 E{(bf16*)(a.ws + WS_PROJ), PW};
    pg8::gemm_phase<EpiStoreBf16, pg8::StaticOrder, PG8_ALIGN, PG8_SP2>(lds, g, S, E);
}
#if XBF16
#define EPI_RESID(XF32) EpiResidB<XF32>
#define EPI_RESID_XIN(p) ((const void*)(p))
#else
#define EPI_RESID(XF32) EpiResid
#define EPI_RESID_XIN(p) ((const float*)(p))
#endif
template <int L, bool XF32> __device__ __forceinline__ void p_outproj_f(const Args& a, LAS unsigned char* lds, const void* xin, XT* xout) {
    pg8::Gemm g{(const bf16*)(a.ws + WS_MIX), (const bf16*)(a.ws + WS_WOUT_T) + (size_t)L * D * D, M, D, D}; pg8::StaticOrder S; S.init(M, D, gridDim.x, blockIdx.x);
    EPI_RESID(XF32) E{EPI_RESID_XIN(xin), xout, (const float*)(a.ws + WS_MOD) + (size_t)L * 4 * D6 + 4096, 1.f};
    pg8::gemm_phase<EPI_RESID(XF32), pg8::StaticOrder, PG8_ALIGN, PG8_SP2>(lds, g, S, E);
}
__device__ __forceinline__ void p_ffn_gateup_f(const Args& a, LAS unsigned char* lds) {
    if (FFN8_GU) { pg8::Gemm g{(const bf16*)(a.ws + WS_HB), (const bf16*)(a.ws + WS_FGU_T), M, 2 * DFF, D / 2}; pg8::StaticOrder S; S.init(M, 2 * DFF, gridDim.x, blockIdx.x);
        if (FFN8_DN) { EpiSwiglu8 E{a.ws + WS_HID, DFF, 1.f / F8_WGU}; pg8::gemm_phase<EpiSwiglu8, pg8::StaticOrder, PG8_ALIGN, PG8_SP2, true>(lds, g, S, E); }
        else { EpiSwiglu E{(bf16*)(a.ws + WS_HID), DFF, 1.f / F8_WGU}; pg8::gemm_phase<EpiSwiglu, pg8::StaticOrder, PG8_ALIGN, PG8_SP2, true>(lds, g, S, E); }
        return; }
    pg8::Gemm g{(const bf16*)(a.ws + WS_HB), (const bf16*)(a.ws + WS_FGU_T), M, 2 * DFF, D}; pg8::StaticOrder S; S.init(M, 2 * DFF, gridDim.x, blockIdx.x);
    if (FFN8_DN) { EpiSwiglu8 E{a.ws + WS_HID, DFF, 1.f}; pg8::gemm_phase<EpiSwiglu8, pg8::StaticOrder, PG8_ALIGN, PG8_SP2>(lds, g, S, E); }
    else { EpiSwiglu E{(bf16*)(a.ws + WS_HID), DFF, 1.f}; pg8::gemm_phase<EpiSwiglu, pg8::StaticOrder, PG8_ALIGN, PG8_SP2>(lds, g, S, E); }
}
template <int L> __device__ __forceinline__ void p_ffn_down_f(const Args& a, LAS unsigned char* lds, const XT* X, XT* xout) {
    if (FFN8_DN) { pg8::Gemm g{(const bf16*)(a.ws + WS_HID), (const bf16*)(a.ws + WS_FD_T), M, D, DFF / 2}; pg8::StaticOrder S; S.init(M, D, gridDim.x, blockIdx.x);
        EPI_RESID(false) E{EPI_RESID_XIN(X), xout, (const float*)(a.ws + WS_MOD) + (size_t)L * 4 * D6 + 10240, 1.f / F8_FD};
        pg8::gemm_phase<EPI_RESID(false), pg8::StaticOrder, PG8_ALIGN, PG8_SP2, true>(lds, g, S, E); return; }
    pg8::Gemm g{(const bf16*)(a.ws + WS_HID), (const bf16*)(a.ws + WS_FD_T), M, D, DFF}; pg8::StaticOrder S; S.init(M, D, gridDim.x, blockIdx.x);
    EPI_RESID(false) E{EPI_RESID_XIN(X), xout, (const float*)(a.ws + WS_MOD) + (size_t)L * 4 * D6 + 10240, 1.f};
    pg8::gemm_phase<EPI_RESID(false), pg8::StaticOrder, PG8_ALIGN, PG8_SP2>(lds, g, S, E);
}
__device__ __forceinline__ void p_moe_gateup_f(const Args& a, LAS unsigned char* lds) {
    const int* moe_base = (const int*)(a.ws + WS_ROUTE + 512 * 1024);
    if (MOE_FP8) { pg8::Gemm g{(const bf16*)(a.ws + WS_HPERM), (const bf16*)(a.ws + WS_MGU_T), MOE_ROWS, 2 * DFE, D / 2}; MoeOrder S; S.init(moe_base, 2 * DFE, gridDim.x, blockIdx.x);
        EpiSwiglu8 E{a.ws + WS_HID, DFE, 1.f / F8_WGU};
        pg8::gemm_phase<EpiSwiglu8, MoeOrder, PG8_ALIGN, PG8_SP2, true>(lds, g, S, E); return; }
    pg8::Gemm g{(const bf16*)(a.ws + WS_HPERM), (const bf16*)(a.ws + WS_MGU_T), MOE_ROWS, 2 * DFE, D}; MoeOrder S; S.init(moe_base, 2 * DFE, gridDim.x, blockIdx.x);
    EpiSwiglu E{(bf16*)(a.ws + WS_HID), DFE, 1.f};
    pg8::gemm_phase<EpiSwiglu, MoeOrder, PG8_ALIGN, PG8_SP2>(lds, g, S, E);
}
__device__ __forceinline__ void p_moe_down_f(const Args& a, LAS unsigned char* lds) {
    const int* moe_base = (const int*)(a.ws + WS_ROUTE + 512 * 1024);
    if (MOE_FP8) { pg8::Gemm g{(const bf16*)(a.ws + WS_HID), (const bf16*)(a.ws + WS_MD_T), MOE_ROWS, D, DFE / 2}; MoeOrder S; S.init(moe_base, D, gridDim.x, blockIdx.x);
        EpiBf16S E{(bf16*)(a.ws + WS_Y), D, 1.f / F8_WD};
        pg8::gemm_phase<EpiBf16S, MoeOrder, PG8_ALIGN, PG8_SP2, true>(lds, g, S, E); return; }
    pg8::Gemm g{(const bf16*)(a.ws + WS_HID), (const bf16*)(a.ws + WS_MD_T), MOE_ROWS, D, DFE}; MoeOrder S; S.init(moe_base, D, gridDim.x, blockIdx.x);
    EpiF32 E{(float*)(a.ws + WS_Y), D};
    pg8::gemm_phase<EpiF32, MoeOrder, PG8_ALIGN, PG8_SP2>(lds, g, S, E);
}

constexpr int NPHASE = 25;

__global__ void __launch_bounds__(512, 2) mk_fwd(Args a) {
    extern __shared__ __attribute__((aligned(16))) unsigned char lds_raw[];
    LAS unsigned char* lds = (LAS unsigned char*)lds_raw;
    volatile LAS unsigned* MISC = (volatile LAS unsigned*)(lds + MISC_OFF);
    if (threadIdx.x < 64) MISC[threadIdx.x] = 0u;
    __syncthreads();
    const int lo = a.ph_lo, hi = a.ph_hi;
#if ONE_LAUNCH
    XcdBarrier bar = xcd_barrier_post((unsigned*)(a.ws + WS_CTL) + CW_BAR, MISC + 8);
#define SEAM(k) do { if (lo <= (k) && (k) + 1 < hi) xcd_barrier(bar); } while (0)
#else
#define SEAM(k) do { } while (0)
#endif
#ifndef PHMASK
#define PHMASK 0xFFFFFFFFu
#endif
#define IN(k) (((PHMASK >> (k)) & 1u) && lo <= (k) && (k) < hi)
#ifndef DBLMASK
#define DBLMASK 0u
#endif
#define DBL(k) ((((unsigned)DBLMASK >> (k)) & 1u) != 0u)
#ifndef DBLSUB
#define DBLSUB 0u
#endif
#define DSUB(b) ((((unsigned)DBLSUB >> (b)) & 1u) != 0u)
    static_assert(!XBF16 || FAST_GEMM, "the bf16 residual stream is wired through the fast GEMM phases only");
    XT* XA = (XT*)(a.ws + WS_XA);
    XT* XB = XBF16 ? (XT*)(a.ws + WS_XA + (size_t)M * D * 2) : (XT*)a.out;
    const float* MOD = (const float*)(a.ws + WS_MOD);
    if (IN(0)) { p0_mod(a, lds); if (FAST_GEMM) p0_weights(a, lds); if (FAST_CMP) p0_cmp_weights(a, lds); if (DBL(0)) { p0_mod(a, lds); if (FAST_GEMM) p0_weights(a, lds); if (FAST_CMP) p0_cmp_weights(a, lds); } } SEAM(0);
    if (IN(1)) { if (FAST_GEMM) p_mod_rows(a, a.in[I_X], MOD, MOD + 2048); if (DBL(1)) { if (FAST_GEMM) p_mod_rows(a, a.in[I_X], MOD, MOD + 2048); } } SEAM(1);
    if (IN(2)) { if (FAST_GEMM) p_inproj_f<0>(a, lds); else p_inproj_g<0>(a, lds, a.in[I_X]); if (DBL(2)) { if (FAST_GEMM) p_inproj_f<0>(a, lds); else p_inproj_g<0>(a, lds, a.in[I_X]); } } SEAM(2);
    if (IN(3)) { if (FAST_CMP) { p_cmp1_f<0>(a, lds); p_rope_la<0, FAST_GLA == 0>(a); } else p_cmp1_g<0>(a, lds); if (FAST_NSA) p_vtrans(a, lds); if (FAST_GLA) p_gla1<0>(a, lds); if (DSUB(2)) p_gla1<0>(a, lds); if (DSUB(0)) p_cmp1_f<0>(a, lds); if (DSUB(1)) p_vtrans(a, lds); if (DBL(3)) { if (FAST_CMP) { p_cmp1_f<0>(a, lds);  } else p_cmp1_g<0>(a, lds); if (FAST_NSA) p_vtrans(a, lds); if (FAST_GLA) p_gla1<0>(a, lds); } } SEAM(3);
    if (IN(4)) { if (FAST_CMP) p_cmp2_f<0>(a); else p_cmp2_g<0>(a, lds); if (FAST_GLA) p_gla2(a); if (DBL(4)) { if (FAST_CMP) p_cmp2_f<0>(a); else p_cmp2_g<0>(a, lds); if (FAST_GLA) p_gla2(a); } } SEAM(4);
    if (IN(5)) { if (FAST_NSA) p_nsa_f(a, lds); else p_nsa_g(a, lds); if (FAST_GLA) p_gla3<0>(a, lds); if (DSUB(4)) p_nsa_f(a, lds); if (DSUB(5)) p_gla3<0>(a, lds); if (DBL(5)) { if (FAST_NSA) p_nsa_f(a, lds); else p_nsa_g(a, lds); if (FAST_GLA) p_gla3<0>(a, lds); } } SEAM(5);
    if (!FAST_GLA) { if (IN(6)) { p_gla_g(a); if (DBL(6)) { p_gla_g(a); } } SEAM(6);
    if (IN(7)) { p_glapost<0>(a); if (DBL(7)) { p_glapost<0>(a); } } SEAM(7); }
    if (IN(8)) { if (FAST_GEMM) p_outproj_f<0, true>(a, lds, a.in[I_X], XA); else p_outproj_g<0>(a, lds, a.in[I_X], (float*)XA); if (DBL(8)) { if (FAST_GEMM) p_outproj_f<0, true>(a, lds, a.in[I_X], XA); else p_outproj_g<0>(a, lds, a.in[I_X], (float*)XA); } } SEAM(8);
    if (IN(9)) { p_ln_mix<0, false, FAST_GEMM != 0>(a, lds, XA); if (DBL(9)) { p_ln_mix<0, false, FAST_GEMM != 0>(a, lds, XA); } } SEAM(9);
    if (IN(10)) { if (FAST_GEMM) p_ffn_gateup_f(a, lds); else p_ffn_gateup_g<0>(a, lds, (float*)XA); if (DBL(10)) { if (FAST_GEMM) p_ffn_gateup_f(a, lds); else p_ffn_gateup_g<0>(a, lds, (float*)XA); } } SEAM(10);
    if (IN(11)) { if (FAST_GEMM) p_ffn_down_f<0>(a, lds, XA, XB); else p_ffn_down_g<0>(a, lds, (float*)XA, a.out); if (DBL(11)) { if (FAST_GEMM) p_ffn_down_f<0>(a, lds, XA, XB); else p_ffn_down_g<0>(a, lds, (float*)XA, a.out); } } SEAM(11);
    if (IN(12)) { p_ln_ffn<0, FAST_GEMM != 0>(a, XB); if (DBL(12)) { p_ln_ffn<0, FAST_GEMM != 0>(a, XB); } } SEAM(12);
    if (IN(13)) { if (FAST_GEMM) p_inproj_f<1>(a, lds); else p_inproj_g<1>(a, lds, a.out); if (DBL(13)) { if (FAST_GEMM) p_inproj_f<1>(a, lds); else p_inproj_g<1>(a, lds, a.out); } } SEAM(13);
    if (IN(14)) { if (FAST_CMP) { p_cmp1_f<1>(a, lds); p_rope_la<1, FAST_GLA == 0>(a); } else p_cmp1_g<1>(a, lds); if (FAST_NSA) p_vtrans(a, lds); if (FAST_GLA) p_gla1<1>(a, lds); if (DSUB(2)) p_gla1<1>(a, lds); if (DSUB(0)) p_cmp1_f<1>(a, lds); if (DSUB(1)) p_vtrans(a, lds); if (DBL(14)) { if (FAST_CMP) { p_cmp1_f<1>(a, lds);  } else p_cmp1_g<1>(a, lds); if (FAST_NSA) p_vtrans(a, lds); if (FAST_GLA) p_gla1<1>(a, lds); } } SEAM(14);
    if (IN(15)) { if (FAST_CMP) p_cmp2_f<1>(a); else p_cmp2_g<1>(a, lds); if (FAST_GLA) p_gla2(a); if (DBL(15)) { if (FAST_CMP) p_cmp2_f<1>(a); else p_cmp2_g<1>(a, lds); if (FAST_GLA) p_gla2(a); } } SEAM(15);
    if (IN(16)) { if (FAST_NSA) p_nsa_f(a, lds); else p_nsa_g(a, lds); if (FAST_GLA) p_gla3<1>(a, lds); if (DSUB(4)) p_nsa_f(a, lds); if (DSUB(5)) p_gla3<1>(a, lds); if (DBL(16)) { if (FAST_NSA) p_nsa_f(a, lds); else p_nsa_g(a, lds); if (FAST_GLA) p_gla3<1>(a, lds); } } SEAM(16);
    if (!FAST_GLA) { if (IN(17)) { p_gla_g(a); if (DBL(17)) { p_gla_g(a); } } SEAM(17);
    if (IN(18)) { p_glapost<1>(a); if (DBL(18)) { p_glapost<1>(a); } } SEAM(18); }
    if (IN(19)) { if (FAST_GEMM) p_outproj_f<1, XBF16 == 0>(a, lds, XB, XA); else p_outproj_g<1>(a, lds, a.out, (float*)XA); if (DBL(19)) { if (FAST_GEMM) p_outproj_f<1, XBF16 == 0>(a, lds, XB, XA); else p_outproj_g<1>(a, lds, a.out, (float*)XA); } } SEAM(19);
    if (IN(20)) { p_ln_mix<1, true, false>(a, lds, XA); if (DBL(20)) { p_ln_mix<1, true, false>(a, lds, XA); } } SEAM(20);
    if (IN(21)) { p_moe_slots<1>(a, lds, XA); if (DBL(21)) { p_moe_slots<1>(a, lds, XA); } } SEAM(21);
    if (IN(22)) { if (FAST_GEMM) p_moe_gateup_f(a, lds); else p_moe_gateup_g(a, lds); if (DBL(22)) { if (FAST_GEMM) p_moe_gateup_f(a, lds); else p_moe_gateup_g(a, lds); } } SEAM(22);
    if (IN(23)) { if (FAST_GEMM) p_moe_down_f(a, lds); else p_moe_down_g(a, lds); if (DBL(23)) { if (FAST_GEMM) p_moe_down_f(a, lds); else p_moe_down_g(a, lds); } } SEAM(23);
    if (IN(24)) { p_moe_combine_ln<1>(a, XA, a.out); }
#undef IN
#undef SEAM
}

extern "C" void kernel_launch(void* const* d_in, const int* in_sizes, int n_in, void* d_out, int out_size, void* d_ws, size_t ws_size, hipStream_t stream) {
    static int grid = 0;
    if (grid == 0) {
        if (n_in != 26 || out_size != M * D || ws_size < WS_END3) { fprintf(stderr, "kernel_launch: unexpected shapes (n_in %d out %d ws %zu)\n", n_in, out_size, ws_size); grid = -1; return; }
        int dev = 0, cus = 0;
        if (hipGetDevice(&dev) != hipSuccess || hipDeviceGetAttribute(&cus, hipDeviceAttributeMultiprocessorCount, dev) != hipSuccess) { grid = -1; return; }
        if (hipFuncSetAttribute((const void*)mk_fwd, hipFuncAttributeMaxDynamicSharedMemorySize, LDS_BYTES) != hipSuccess) { fprintf(stderr, "kernel_launch: hipFuncSetAttribute failed\n"); grid = -1; return; }
        int per_cu = 0;
        if (hipOccupancyMaxActiveBlocksPerMultiprocessor(&per_cu, (const void*)mk_fwd, 512, LDS_BYTES) != hipSuccess || per_cu < 1) { fprintf(stderr, "kernel_launch: occupancy query says %d\n", per_cu); }
        (void)hipGetLastError();
        grid = cus;
    }
    if (grid < 0) return;
    (void)hipMemsetAsync((char*)d_ws + WS_CTL, 0, CTL_ZERO_BYTES, stream);
    Args a{};
    for (int i = 0; i < 26; ++i) a.in[i] = (const float*)d_in[i];
    a.out = (float*)d_out; a.ws = (unsigned char*)d_ws; a.pad0 = 0; a.pad1 = 0;
#if ONE_LAUNCH
    a.ph_lo = 0; a.ph_hi = NPHASE;
    hipLaunchKernelGGL(mk_fwd, dim3(grid), dim3(512), LDS_BYTES, stream, a);
#else
#ifndef HOST_DBLMASK
#define HOST_DBLMASK 0u
#endif
    for (int ph = 0; ph < NPHASE; ++ph) {
        a.ph_lo = ph; a.ph_hi = ph + 1;
        for (int rep = 0; rep < ((((unsigned)HOST_DBLMASK >> ph) & 1u) ? 2 : 1); ++rep)
            hipLaunchKernelGGL(mk_fwd, dim3(grid), dim3(512), LDS_BYTES, stream, a);
    }
#endif
}
```

```cpp
#include <hip/hip_runtime.h>
#include <cstdio>
#include <cstdint>

#ifndef ONE_LAUNCH
#define ONE_LAUNCH 1
#endif
#ifndef FAST_GEMM
#define FAST_GEMM 1
#endif
#ifndef FAST_NSA
#define FAST_NSA 1
#endif
#ifndef FAST_CMP
#define FAST_CMP 1
#endif
#ifndef FAST_GLA
#define FAST_GLA 1
#endif

#define GAS __attribute__((address_space(1)))
#define LAS __attribute__((address_space(3)))
typedef unsigned short bf16;
typedef float f32x4 __attribute__((ext_vector_type(4)));
typedef float f32x2 __attribute__((ext_vector_type(2)));
typedef unsigned u32x4 __attribute__((ext_vector_type(4)));
typedef unsigned u32x2 __attribute__((ext_vector_type(2)));

constexpr int NB = 4, T = 4096, M = NB * T, D = 2048, D6 = 6 * D;
constexpr int INW = 5672, PW = 5888;
constexpr int PQ = 0, PKC = 1024, PVC = 1280, PKS = 1536, PVS = 1792, PKW = 2048, PVW = 2304, PGQ = 2560, PGK = 3072, PGV = 3584, PGG = 4608, PNG = 5632, PGA = 5656;
constexpr int DFF = 5632, DFE = 7168, NE = 8;
constexpr int MOE_ROWS = 2 * M + NE * 256;
constexpr float LN_EPS = 1e-5f, NORM_EPS = 1e-6f, ALPHA = 1.4142135623730951f, QSCALE = 0.08838834764831845f;
constexpr int NCR = 2048;

constexpr size_t MiB = 1u << 20;
constexpr size_t WS_CTL = 0, CTL_ZERO_BYTES = 1 * MiB;
constexpr size_t WS_MOD = 1 * MiB;
constexpr size_t WS_ROPE = 2 * MiB;
constexpr size_t WS_KC = 3 * MiB;
constexpr size_t WS_CHID = 5 * MiB;
constexpr size_t WS_ROUTE = 10 * MiB;
constexpr size_t WS_LA = 12 * MiB;
constexpr size_t WS_XA = 44 * MiB;
constexpr size_t WS_PROJ = 172 * MiB;
constexpr size_t WS_MIX = 356 * MiB;
constexpr size_t WS_GLAO = 420 * MiB;
constexpr size_t WS_HID = 172 * MiB;
constexpr size_t WS_HPERM = 648 * MiB;
constexpr size_t WS_Y = 784 * MiB;
constexpr size_t WS_END = 1056 * MiB;
static_assert(WS_HID + (size_t)MOE_ROWS * DFE * 2 <= WS_HPERM && WS_HPERM + (size_t)MOE_ROWS * D * 2 <= WS_Y && WS_Y + (size_t)MOE_ROWS * D * 4 <= WS_END, "ws map");
static_assert(WS_PROJ + (size_t)M * PW * 2 <= WS_MIX && WS_MIX + (size_t)M * 2048 * 2 <= WS_GLAO && WS_GLAO + (size_t)M * 1024 * 4 <= WS_HPERM, "ws map 2");

constexpr int VTP = 4096 + 64;
constexpr size_t WS_VTS = 1856 * MiB;
constexpr size_t WS_VTW = 1865 * MiB;
constexpr size_t WS_KCB = 1874 * MiB;
constexpr size_t WS_VCT = 1875 * MiB;
constexpr size_t WS_CW1T = 1876 * MiB;
constexpr size_t WS_CW2T = 1885 * MiB;
constexpr size_t WS_CPART = 1886 * MiB;
constexpr size_t WS_CHIDB = 1887 * MiB;
constexpr size_t WS_END3 = 1889 * MiB;
static_assert(WS_VTS + (size_t)8 * 128 * VTP * 2 <= WS_VTW && WS_VTW + (size_t)8 * 128 * VTP * 2 <= WS_KCB && WS_CW1T + (size_t)4 * 256 * VTP * 2 <= WS_CW2T, "tail map");
constexpr int CW_BAR = 4096;

constexpr int SCR_BYTES = 148480;
constexpr int MISC_OFF = SCR_BYTES;
constexpr int LDS_BYTES = SCR_BYTES + 1024;

__device__ __forceinline__ unsigned f2bf(float f) { unsigned u = __builtin_bit_cast(unsigned, f); return (u + 0x7fffu + ((u >> 16) & 1u)) >> 16; }
__device__ __forceinline__ unsigned pk2(float lo, float hi) { return f2bf(lo) | (f2bf(hi) << 16); }
__device__ __forceinline__ float bflo(unsigned w) { return __builtin_bit_cast(float, w << 16); }
__device__ __forceinline__ float bfhi(unsigned w) { return __builtin_bit_cast(float, w & 0xffff0000u); }
__device__ __forceinline__ float bf1(bf16 b) { return __builtin_bit_cast(float, ((unsigned)b) << 16); }
__device__ __forceinline__ float wave_sum(float v) {
#pragma unroll
    for (int o = 1; o < 64; o <<= 1) v += __shfl_xor(v, o);
    return v;
}
__device__ __forceinline__ float wave_max(float v) {
#pragma unroll
    for (int o = 1; o < 64; o <<= 1) v = fmaxf(v, __shfl_xor(v, o));
    return v;
}
__device__ __forceinline__ float sigmoidf_(float x) { return 1.f / (1.f + __expf(-x)); }
__device__ __forceinline__ float siluf_(float x) { return x / (1.f + __expf(-x)); }
__device__ __forceinline__ float gelu_tanh(float x) { const float u = 0.7978845608028654f * (x + 0.044715f * x * x * x); const float e = __expf(2.f * u); const float th = 1.f - 2.f / (e + 1.f); return 0.5f * x * (1.f + th); }

__device__ __forceinline__ f32x4 ld_bf4(const bf16* p) { const u32x2 w = *(const u32x2*)p; return (f32x4){bflo(w.x), bfhi(w.x), bflo(w.y), bfhi(w.y)}; }
__device__ __forceinline__ void st_bf4(bf16* p, f32x4 v) { u32x2 w; w.x = pk2(v.x, v.y); w.y = pk2(v.z, v.w); *(u32x2*)p = w; }
#ifndef XBF16
#define XBF16 1
#endif
#if XBF16
typedef bf16 XT; typedef u32x2 XRaw;
__device__ __forceinline__ XRaw ldxr(const XT* p) { return *(const u32x2*)p; }
__device__ __forceinline__ f32x4 xr2f(XRaw w) { return (f32x4){bflo(w.x), bfhi(w.x), bflo(w.y), bfhi(w.y)}; }
__device__ __forceinline__ void stx4(XT* p, f32x4 v) { st_bf4(p, v); }
#else
typedef float XT; typedef f32x4 XRaw;
__device__ __forceinline__ XRaw ldxr(const XT* p) { return *(const f32x4*)p; }
__device__ __forceinline__ f32x4 xr2f(XRaw w) { return w; }
__device__ __forceinline__ void stx4(XT* p, f32x4 v) { *(f32x4*)p = v; }
#endif

#define XB_TMO      128
#define XB_XCNT(j)  (256  + 64 * (j))
#define XB_XSUB(j)  (1280 + 64 * (j))
#define XB_XGEN(j)  (2304 + 64 * (j))
#define XB_TOP      3328
#define XB_TOPGEN   3392
#define XCD_BAR_WORDS 3456
#define XB_SPIN_CAP (1u << 22)
__device__ __forceinline__ unsigned xb_ld(unsigned* p)              { return __hip_atomic_load(p, __ATOMIC_RELAXED, __HIP_MEMORY_SCOPE_AGENT); }
__device__ __forceinline__ unsigned xb_add(unsigned* p, unsigned v) { return __hip_atomic_fetch_add(p, v, __ATOMIC_RELAXED, __HIP_MEMORY_SCOPE_AGENT); }
__device__ __forceinline__ unsigned xb_xcc_id() { return (unsigned)__builtin_amdgcn_s_getreg((3 << 11) | 20) & 0xFu; }
#define XB_SPIN(cond, bar) do { unsigned _sp = 0; while (cond) { __builtin_amdgcn_s_sleep(1); \
    if ((++_sp & 255u) == 0u) { if (xb_ld(&(bar)[XB_TMO])) break; if (_sp > XB_SPIN_CAP) { atomicAdd(&(bar)[XB_TMO], 1u); break; } } } } while (0)
struct XcdBarrier { unsigned* bar; unsigned x; volatile LAS unsigned* st; };
__device__ __forceinline__ XcdBarrier xcd_barrier_post(unsigned* bar, volatile LAS unsigned* st) {
    XcdBarrier b; b.bar = bar; b.x = xb_xcc_id(); b.st = st;
    if (threadIdx.x == 0) (void)xb_add(&bar[XB_XCNT(b.x)], 1u);
    return b;
}
__device__ __forceinline__ void xcd_barrier_complete(unsigned* bar, unsigned x, unsigned& nloc, unsigned& nx) {
    const unsigned G = gridDim.x * gridDim.y * gridDim.z;
    unsigned sum, cnt, mine, sp = 0u;
    for (;;) {
        sum = 0u; cnt = 0u; mine = 0u;
#pragma unroll
        for (unsigned j = 0; j < 16; ++j) { const unsigned c = xb_ld(&bar[XB_XCNT(j)]); sum += c; cnt += (c > 0u) ? 1u : 0u; mine = (j == x) ? c : mine; }
        if (sum == G) break;
        __builtin_amdgcn_s_sleep(1);
        if ((++sp & 255u) == 0u) { if (xb_ld(&bar[XB_TMO])) break; if (sp > XB_SPIN_CAP) { atomicAdd(&bar[XB_TMO], 1u); break; } }
    }
    nloc = mine > 0u ? mine : 1u; nx = cnt > 0u ? cnt : 1u;
}
__device__ __forceinline__ void xcd_barrier(const XcdBarrier& b) {
    asm volatile("s_waitcnt vmcnt(0)" ::: "memory");
    __syncthreads();
    if (threadIdx.x == 0) {
        unsigned* bar = b.bar;
        __builtin_amdgcn_s_waitcnt(0);
        unsigned nloc = b.st[0], nx = b.st[1];
        if (nloc == 0u) { xcd_barrier_complete(bar, b.x, nloc, nx); b.st[0] = nloc; b.st[1] = nx; }
        const unsigned old = xb_add(&bar[XB_XSUB(b.x)], 1u);
        const unsigned gen = old / nloc;
        if (old + 1u == (gen + 1u) * nloc) {
            __builtin_amdgcn_fence(__ATOMIC_RELEASE, "agent");
            asm volatile("s_waitcnt vmcnt(0)" ::: "memory");
            const unsigned og = xb_add(&bar[XB_TOP], 1u);
            const unsigned tg = og / nx;
            if (og + 1u == (tg + 1u) * nx) xb_add(&bar[XB_TOPGEN], 1u);
            else XB_SPIN(xb_ld(&bar[XB_TOPGEN]) == tg, bar);
            __builtin_amdgcn_fence(__ATOMIC_ACQUIRE, "agent");
            xb_add(&bar[XB_XGEN(b.x)], 1u);
            asm volatile("s_waitcnt vmcnt(0)" ::: "memory");
        } else {
            XB_SPIN(xb_ld(&bar[XB_XGEN(b.x)]) == gen, bar);
            __builtin_amdgcn_fence(__ATOMIC_ACQUIRE, "agent");
            asm volatile("s_waitcnt vmcnt(0)" ::: "memory");
        }
    }
    __syncthreads();
}

struct Args { const float* in[26]; float* out; unsigned char* ws; int ph_lo, ph_hi, pad0, pad1; };
enum { I_X = 0, I_C, I_WADA, I_BADA, I_WIN, I_CPK, I_CW1K, I_CW2K, I_CPV, I_CW1V, I_CW2V, I_GWA2, I_GBA, I_GNW, I_WOUT, I_LMG, I_LMB, I_LFG, I_LFB,
       I_FWG, I_FWU, I_FWD, I_MR, I_MWG, I_MWU, I_MWD };

namespace pg8 {
#define PG8_LAS __attribute__((address_space(3)))
typedef unsigned short bf16_t;
typedef short bf16x8 __attribute__((ext_vector_type(8)));
typedef float f32x4 __attribute__((ext_vector_type(4)));
typedef unsigned u32x4 __attribute__((ext_vector_type(4)));
constexpr int BM = 256, BK = 64, HALF = 128, HTB = HALF * BK * 2  , STAGE_BYTES = 8 * HTB, NXCD = 8, WGM = 8;

__host__ __device__ __forceinline__ int lds_byte(int r, int c) { const int st = (r >> 4) * 2 + (c >> 5), rr = r & 15, cc = c & 31, ob = rr * 64 + cc * 2; return st * 1024 + (ob ^ (((ob >> 9) & 1) << 5)); }
__host__ __device__ __forceinline__ void stage_rc(int b, int& R, int& C) { const int st = b / 1024, sb = b % 1024, swz = sb ^ (((sb >> 9) & 1) << 5); R = (st >> 1) * 16 + swz / 64; C = (st & 1) * 32 + (swz % 64) / 2; }
__host__ __device__ __forceinline__ int perm32(int rho) { const int n = rho >> 4, i = rho & 15; return 8 * (i >> 2) + 4 * n + (i & 3); }

struct Unit { int pm, pn, pb; };
struct Gemm { const bf16_t* A; const bf16_t* Bt; int M, N, K; };

struct StaticOrder {
    int nM, nN, nwg, G, c;
    __host__ __device__ void init(int M, int N, int G_, int c_) { nM = M / BM; nN = N / BM; nwg = nM * nN; G = G_; c = c_; }
    __host__ __device__ bool next(int i, Unit& u) const {
        const long L = (long)i * G + c; if (L >= nwg) return false;
        int wgid = (int)L; { const int q = nwg / NXCD, r = nwg % NXCD, xcd = wgid % NXCD, off = wgid / NXCD; wgid = (xcd < r ? xcd * (q + 1) : r * (q + 1) + (xcd - r) * q) + off; }
        const int nig = WGM * nN, gid = wgid / nig, fm = gid * WGM, gsz = (nM - fm) < WGM ? (nM - fm) : WGM;
        u.pm = fm + ((wgid % nig) % gsz); u.pn = (wgid % nig) / gsz; u.pb = u.pn; return true;
    }
    __device__ __forceinline__ void a_ready(const Unit&) const {}
    __device__ __forceinline__ void done(const Unit&) const {}
};

__device__ __forceinline__ unsigned cvt_pk_bf16(float lo, float hi) { unsigned r; asm volatile("v_cvt_pk_bf16_f32 %0, %1, %2" : "=v"(r) : "v"(lo), "v"(hi)); return r; }
typedef float f32x2 __attribute__((ext_vector_type(2)));

typedef int i32x8 __attribute__((ext_vector_type(8))); typedef int i32x4 __attribute__((ext_vector_type(4)));
__device__ __forceinline__ i32x8 cat8(bf16x8 lo, bf16x8 hi) { const i32x4 a = __builtin_bit_cast(i32x4, lo), b = __builtin_bit_cast(i32x4, hi); return (i32x8){a.x, a.y, a.z, a.w, b.x, b.y, b.z, b.w}; }
template <class Epi, class Sched, bool ALIGN_EPI = false, bool SP2 = false, bool FP8 = false>
__device__ __forceinline__ void gemm_phase(PG8_LAS unsigned char* lds, const Gemm g, const Sched& S, const Epi& E) {
    const int tid = threadIdx.x, wid = __builtin_amdgcn_readfirstlane(tid >> 6), lane = tid & 63, wr = wid >> 2, wc = wid & 3, fr = lane & 15, fq = lane >> 4;
    const int K = g.K, nt = K / BK;
    unsigned voffA[2], voffB[2];
#pragma unroll
    for (int i = 0; i < 2; ++i) { int R, C; stage_rc(tid * 16 + i * 8192, R, C); const int Rb = Epi::PERM ? ((R & ~31) + perm32(R & 31)) : R;
        voffA[i] = (unsigned)(R * K + C) * 2u; voffB[i] = (unsigned)(Rb * K + C) * 2u; }
    const size_t kstep = (size_t)(BK * 2);
    const size_t hstep = (size_t)HALF * K * 2;
    const size_t tstep = 2 * hstep;
    const unsigned ldsw = (unsigned)wid * 1024u;
    const int aoff = lds_byte(wr * 64 + fr, fq * 8), boff = lds_byte(wc * 32 + fr, fq * 8);
#define PG8_SA(b, h) (((b) * 2 + (h)) * HTB)
#define PG8_SB(b, h) ((4 + (b) * 2 + (h)) * HTB)
#define PG8_STAGE(bufoff, gbase, voff) do { _Pragma("unroll") for (int _i = 0; _i < 2; ++_i) \
        __builtin_amdgcn_global_load_lds((const unsigned*)((const char*)(gbase) + (voff)[_i]), (PG8_LAS unsigned*)(lds + (bufoff) + ldsw + _i * 8192), 16, 0, 0); } while (0)
#define PG8_LDA(dst, b, h) do { _Pragma("unroll") for (int m = 0; m < 4; ++m) _Pragma("unroll") for (int k = 0; k < 2; ++k) dst[m][k] = *(const PG8_LAS bf16x8*)(lds + PG8_SA(b, h) + aoff + m * 2048 + k * 1024); } while (0)
#define PG8_LDB(dst, b, h) do { _Pragma("unroll") for (int n = 0; n < 2; ++n) _Pragma("unroll") for (int k = 0; k < 2; ++k) dst[n][k] = *(const PG8_LAS bf16x8*)(lds + PG8_SB(b, h) + boff + n * 2048 + k * 1024); } while (0)
#define PG8_MMA(ai, bj, At, Bt) do { __builtin_amdgcn_s_setprio(1); _Pragma("unroll") for (int m = 0; m < 4; ++m) _Pragma("unroll") for (int n = 0; n < 2; ++n) { \
        if constexpr (FP8) { asm volatile("v_mfma_f32_16x16x128_f8f6f4 %0, %1, %2, %0" : "+v"(acc[ai][bj][m][n]) : "v"(cat8(Bt[n][0], Bt[n][1])), "v"(cat8(At[m][0], At[m][1]))); } \
        else { _Pragma("unroll") for (int k = 0; k < 2; ++k) acc[ai][bj][m][n] = __builtin_amdgcn_mfma_f32_16x16x32_bf16(Bt[n][k], At[m][k], acc[ai][bj][m][n], 0, 0, 0); } } __builtin_amdgcn_s_setprio(0); } while (0)
#define PG8_WAIT_V(n) asm volatile("s_waitcnt vmcnt(" #n ")" ::: "memory")
#define PG8_WAIT_L(n) asm volatile("s_waitcnt lgkmcnt(" #n ")" ::: "memory")
#define PG8_BAR __builtin_amdgcn_s_barrier()
#define PG8_SCHED __builtin_amdgcn_sched_barrier(0)
    Unit cur, nxt; int ui = 0;
    if (!S.next(0, cur)) return;
    f32x4 acc[2][2][4][2];
#pragma unroll
    for (int a = 0; a < 2; ++a)
#pragma unroll
        for (int b = 0; b < 2; ++b)
#pragma unroll
            for (int m = 0; m < 4; ++m)
#pragma unroll
                for (int n = 0; n < 2; ++n) acc[a][b][m][n] = (f32x4){0.f, 0.f, 0.f, 0.f};
    bf16x8 At[4][2], B0[2][2], B1[2][2];
    const char* cA = (const char*)g.A + (size_t)cur.pm * tstep; const char* cB = (const char*)g.Bt + (size_t)cur.pb * tstep;
    S.a_ready(cur);
    if constexpr (SP2) {
        PG8_STAGE(PG8_SB(0, 0), cB, voffB); PG8_STAGE(PG8_SB(0, 1), cB + hstep, voffB); PG8_STAGE(PG8_SA(0, 0), cA, voffA); PG8_STAGE(PG8_SA(0, 1), cA + hstep, voffA);
        if (wr == 1) PG8_BAR;
        PG8_WAIT_V(2); PG8_BAR;
        PG8_STAGE(PG8_SB(1, 0), cB + kstep, voffB); PG8_STAGE(PG8_SA(1, 0), cA + kstep, voffA); PG8_STAGE(PG8_SB(1, 1), cB + hstep + kstep, voffB);
        PG8_WAIT_V(6); PG8_BAR;
    } else {
        PG8_STAGE(PG8_SB(0, 0), cB, voffB); PG8_STAGE(PG8_SA(0, 0), cA, voffA); PG8_STAGE(PG8_SB(0, 1), cB + hstep, voffB); PG8_STAGE(PG8_SA(0, 1), cA + hstep, voffA);
        if (wr == 1) PG8_BAR;
        PG8_WAIT_V(4); PG8_BAR;
        PG8_STAGE(PG8_SB(1, 0), cB + kstep, voffB); PG8_STAGE(PG8_SA(1, 0), cA + kstep, voffA); PG8_STAGE(PG8_SB(1, 1), cB + hstep + kstep, voffB);
        PG8_WAIT_V(6); PG8_BAR;
    }
    for (;;) {
        const bool has_next = S.next(ui + 1, nxt);
        const char* nA = has_next ? (const char*)g.A + (size_t)nxt.pm * tstep : cA; const char* nB = has_next ? (const char*)g.Bt + (size_t)nxt.pb * tstep : cB;
        for (int t = 0; t < nt; t += 2) {
            const bool last = (t == nt - 2);
            const char* a1 = cA + (size_t)(t + 1) * kstep;
            const char* a2 = last ? nA : cA + (size_t)(t + 2) * kstep; const char* b2 = last ? nB : cB + (size_t)(t + 2) * kstep;
            const char* a3 = a2 + kstep; const char* b3 = b2 + kstep;
            if (last && has_next) S.a_ready(nxt);
            if constexpr (SP2) {
            PG8_LDB(B0, 0, 0); PG8_LDB(B1, 0, 1); PG8_SCHED; PG8_LDA(At, 0, 0); PG8_STAGE(PG8_SA(1, 1), a1 + hstep, voffA);
            PG8_WAIT_V(8); PG8_WAIT_L(0); PG8_BAR; PG8_MMA(0, 0, At, B0); PG8_MMA(0, 1, At, B1); PG8_BAR; PG8_SCHED;
            PG8_LDA(At, 0, 1); PG8_STAGE(PG8_SB(0, 0), b2, voffB); PG8_STAGE(PG8_SB(0, 1), b2 + hstep, voffB); PG8_STAGE(PG8_SA(0, 0), a2, voffA);
            PG8_WAIT_V(8); PG8_WAIT_L(0); PG8_BAR; PG8_MMA(1, 0, At, B0); PG8_MMA(1, 1, At, B1); PG8_BAR; PG8_SCHED;
            PG8_LDB(B0, 1, 0); PG8_LDB(B1, 1, 1); PG8_SCHED; PG8_LDA(At, 1, 0); PG8_STAGE(PG8_SA(0, 1), a2 + hstep, voffA);
            PG8_WAIT_V(8); PG8_WAIT_L(0); PG8_BAR; PG8_MMA(0, 0, At, B0); PG8_MMA(0, 1, At, B1); PG8_BAR; PG8_SCHED;
            PG8_LDA(At, 1, 1); PG8_STAGE(PG8_SB(1, 0), b3, voffB); PG8_STAGE(PG8_SB(1, 1), b3 + hstep, voffB); PG8_STAGE(PG8_SA(1, 0), a3, voffA);
            PG8_WAIT_V(8); PG8_WAIT_L(0); PG8_BAR; PG8_MMA(1, 0, At, B0); PG8_MMA(1, 1, At, B1); PG8_BAR; PG8_SCHED;
            } else {
            PG8_LDB(B0, 0, 0); PG8_SCHED; PG8_LDA(At, 0, 0); PG8_STAGE(PG8_SA(1, 1), a1 + hstep, voffA);
            PG8_WAIT_L(8); PG8_BAR; PG8_WAIT_L(0); PG8_MMA(0, 0, At, B0); PG8_BAR; PG8_SCHED;
            PG8_LDB(B1, 0, 1); PG8_STAGE(PG8_SB(0, 0), b2, voffB);
            PG8_BAR; PG8_WAIT_L(0); PG8_MMA(0, 1, At, B1); PG8_BAR;
            PG8_LDA(At, 0, 1); PG8_STAGE(PG8_SA(0, 0), a2, voffA);
            PG8_BAR; PG8_WAIT_L(0); PG8_MMA(1, 0, At, B0); PG8_BAR; PG8_SCHED;
            PG8_STAGE(PG8_SB(0, 1), b2 + hstep, voffB);
            PG8_WAIT_V(6); PG8_BAR; PG8_MMA(1, 1, At, B1); PG8_BAR;
            PG8_LDB(B0, 1, 0); PG8_SCHED; PG8_LDA(At, 1, 0); PG8_STAGE(PG8_SA(0, 1), a2 + hstep, voffA);
            PG8_WAIT_L(8); PG8_BAR; PG8_WAIT_L(0); PG8_MMA(0, 0, At, B0); PG8_BAR; PG8_SCHED;
            PG8_LDB(B1, 1, 1); PG8_STAGE(PG8_SB(1, 0), b3, voffB);
            PG8_BAR; PG8_WAIT_L(0); PG8_MMA(0, 1, At, B1); PG8_BAR;
            PG8_LDA(At, 1, 1); PG8_STAGE(PG8_SA(1, 0), a3, voffA);
            PG8_BAR; PG8_WAIT_L(0); PG8_MMA(1, 0, At, B0); PG8_BAR; PG8_SCHED;
            PG8_STAGE(PG8_SB(1, 1), b3 + hstep, voffB);
            PG8_WAIT_V(6); PG8_BAR; PG8_MMA(1, 1, At, B1); PG8_BAR;
            }
        }
        if constexpr (FP8) asm volatile("s_nop 15\n\ts_nop 15\n\ts_nop 15\n\ts_nop 15" ::: "memory");
        if constexpr (ALIGN_EPI) { if (wr == 0) PG8_BAR; }
        if constexpr (!Epi::AFTER_DRAIN) { E(acc, cur, wr, wc, fr, fq); S.done(cur); }
        if (!has_next) break;
#pragma unroll
        for (int a = 0; a < 2; ++a)
#pragma unroll
            for (int b = 0; b < 2; ++b)
#pragma unroll
                for (int m = 0; m < 4; ++m)
#pragma unroll
                    for (int n = 0; n < 2; ++n) acc[a][b][m][n] = (f32x4){0.f, 0.f, 0.f, 0.f};
        cur = nxt; cA = nA; cB = nB; ++ui;
        if constexpr (ALIGN_EPI) { if (wr == 1) PG8_BAR; }
    }
    PG8_WAIT_V(0);
    if constexpr (!ALIGN_EPI) { if (wr == 0) PG8_BAR; }
    PG8_BAR;
    if constexpr (Epi::AFTER_DRAIN) { E.fused(acc, cur, wr, wc, fr, fq, lds, wid, lane); S.done(cur); }
#undef PG8_SA
#undef PG8_SB
#undef PG8_STAGE
#undef PG8_LDA
#undef PG8_LDB
#undef PG8_MMA
#undef PG8_WAIT_V
#undef PG8_WAIT_L
#undef PG8_BAR
#undef PG8_SCHED
}
}

#define PG8_SP2 true
#define PG8_ALIGN true

constexpr size_t WS_WIN_T = 1056 * MiB;
constexpr size_t WS_WOUT_T = 1102 * MiB;
constexpr size_t WS_FGU_T = 1118 * MiB;
constexpr size_t WS_FD_T = 1162 * MiB;
constexpr size_t WS_MGU_T = 1184 * MiB;
constexpr size_t WS_MD_T = 1632 * MiB;
constexpr size_t WS_END2 = 1856 * MiB;
constexpr size_t WS_HB = WS_HPERM;
static_assert(WS_WIN_T + (size_t)2 * PW * D * 2 <= WS_WOUT_T && WS_WOUT_T + (size_t)2 * D * D * 2 <= WS_FGU_T && WS_FGU_T + (size_t)2 * DFF * D * 2 <= WS_FD_T && WS_FD_T + (size_t)DFF * D * 2 <= WS_MGU_T
              && WS_MGU_T + (size_t)NE * 2 * DFE * D * 2 <= WS_MD_T && WS_MD_T + (size_t)NE * DFE * D * 2 <= WS_END2, "weight map");

struct EpiStoreBf16 {
    static constexpr bool PERM = true, AFTER_DRAIN = false;
    bf16* O; int ldc;
    __device__ __forceinline__ void operator()(const f32x4 (&acc)[2][2][4][2], const pg8::Unit& u, int wr, int wc, int fr, int fq) const {
        const int row0 = u.pm * 256 + wr * 64 + fr, col0 = u.pn * 256 + wc * 32 + 8 * fq;
#pragma unroll
        for (int ai = 0; ai < 2; ++ai)
#pragma unroll
            for (int m = 0; m < 4; ++m) { bf16* rowp = O + (size_t)(row0 + ai * 128 + m * 16) * ldc + col0;
#pragma unroll
                for (int bj = 0; bj < 2; ++bj) { const f32x4 v0 = acc[ai][bj][m][0], v1 = acc[ai][bj][m][1]; u32x4 w; w.x = pg8::cvt_pk_bf16(v0[0], v0[1]); w.y = pg8::cvt_pk_bf16(v0[2], v0[3]); w.z = pg8::cvt_pk_bf16(v1[0], v1[1]); w.w = pg8::cvt_pk_bf16(v1[2], v1[3]);
                    *(u32x4*)(rowp + bj * 128) = w; } }
    }
};
struct EpiSwiglu {
    static constexpr bool PERM = true, AFTER_DRAIN = false;
    bf16* O; int ldc; float asc;
    __device__ __forceinline__ void operator()(const f32x4 (&acc)[2][2][4][2], const pg8::Unit& u, int wr, int wc, int fr, int fq) const {
        const int row0 = u.pm * 256 + wr * 64 + fr, col0 = u.pn * 128 + wc * 32 + 8 * fq;
#pragma unroll
        for (int ai = 0; ai < 2; ++ai)
#pragma unroll
            for (int m = 0; m < 4; ++m) { bf16* rowp = O + (size_t)(row0 + ai * 128 + m * 16) * ldc + col0;
                float o[8];
#pragma unroll
                for (int n = 0; n < 2; ++n)
#pragma unroll
                    for (int i = 0; i < 4; ++i) { const float g = acc[ai][0][m][n][i] * asc, up = acc[ai][1][m][n][i] * asc; o[n * 4 + i] = g * __builtin_amdgcn_rcpf(1.f + __expf(-g)) * up; }
                u32x4 w; w.x = pg8::cvt_pk_bf16(o[0], o[1]); w.y = pg8::cvt_pk_bf16(o[2], o[3]); w.z = pg8::cvt_pk_bf16(o[4], o[5]); w.w = pg8::cvt_pk_bf16(o[6], o[7]);
                *(u32x4*)rowp = w; }
    }
};
struct EpiResid {
    static constexpr bool PERM = false, AFTER_DRAIN = false;
    const float* xin; float* out; const float* gmod; float asc;
    __device__ __forceinline__ void operator()(const f32x4 (&acc)[2][2][4][2], const pg8::Unit& u, int wr, int wc, int fr, int fq) const {
        const int row0 = u.pm * 256 + wr * 64 + fr, col0 = u.pn * 256 + wc * 32 + 4 * fq;
        const float* gm = gmod + (size_t)((u.pm * 256) >> 12) * D6 + col0;
        f32x4 gv[2][2];
#pragma unroll
        for (int bj = 0; bj < 2; ++bj)
#pragma unroll
            for (int n = 0; n < 2; ++n) gv[bj][n] = (1.f + *(const f32x4*)(gm + bj * 128 + n * 16)) * asc;
#pragma unroll
        for (int ai = 0; ai < 2; ++ai) {
            f32x4 xv[4][2][2];
#pragma unroll
            for (int m = 0; m < 4; ++m) { const size_t off = (size_t)(row0 + ai * 128 + m * 16) * D + col0;
#pragma unroll
                for (int bj = 0; bj < 2; ++bj)
#pragma unroll
                    for (int n = 0; n < 2; ++n) xv[m][bj][n] = *(const f32x4*)(xin + off + bj * 128 + n * 16); }
            __builtin_amdgcn_sched_barrier(0);
#pragma unroll
            for (int m = 0; m < 4; ++m) { const size_t off = (size_t)(row0 + ai * 128 + m * 16) * D + col0;
#pragma unroll
                for (int bj = 0; bj < 2; ++bj)
#pragma unroll
                    for (int n = 0; n < 2; ++n) *(f32x4*)(out + off + bj * 128 + n * 16) = ALPHA * xv[m][bj][n] + gv[bj][n] * acc[ai][bj][m][n]; }
            __builtin_amdgcn_sched_barrier(0);
        }
    }
};
template <bool XF32> struct EpiResidB {
    static constexpr bool PERM = true, AFTER_DRAIN = false;
    const void* xin; bf16* out; const float* gmod; float asc;
    __device__ __forceinline__ void operator()(const f32x4 (&acc)[2][2][4][2], const pg8::Unit& u, int wr, int wc, int fr, int fq) const {
        const int row0 = u.pm * 256 + wr * 64 + fr, col0 = u.pn * 256 + wc * 32 + 8 * fq;
        const float* gm = gmod + (size_t)((u.pm * 256) >> 12) * D6 + col0;
        f32x4 gv[2][2];
#pragma unroll
        for (int bj = 0; bj < 2; ++bj)
#pragma unroll
            for (int n = 0; n < 2; ++n) gv[bj][n] = (1.f + *(const f32x4*)(gm + bj * 128 + n * 4)) * asc;
#pragma unroll
        for (int ai = 0; ai < 2; ++ai) {
            f32x4 xv[4][2][2]; u32x4 xb[4][2];
#pragma unroll
            for (int m = 0; m < 4; ++m) { const size_t off = (size_t)(row0 + ai * 128 + m * 16) * D + col0;
#pragma unroll
                for (int bj = 0; bj < 2; ++bj) {
                    if (XF32) {
#pragma unroll
                        for (int n = 0; n < 2; ++n) xv[m][bj][n] = *(const f32x4*)((const float*)xin + off + bj * 128 + n * 4); }
                    else xb[m][bj] = *(const u32x4*)((const bf16*)xin + off + bj * 128); } }
            __builtin_amdgcn_sched_barrier(0);
#pragma unroll
            for (int m = 0; m < 4; ++m) { const size_t off = (size_t)(row0 + ai * 128 + m * 16) * D + col0;
#pragma unroll
                for (int bj = 0; bj < 2; ++bj) {
                    f32x4 x0, x1;
                    if (XF32) { x0 = xv[m][bj][0]; x1 = xv[m][bj][1]; }
                    else { const u32x4 w = xb[m][bj]; x0 = (f32x4){bflo(w.x), bfhi(w.x), bflo(w.y), bfhi(w.y)}; x1 = (f32x4){bflo(w.z), bfhi(w.z), bflo(w.w), bfhi(w.w)}; }
                    const f32x4 o0 = ALPHA * x0 + gv[bj][0] * acc[ai][bj][m][0], o1 = ALPHA * x1 + gv[bj][1] * acc[ai][bj][m][1];
                    u32x4 pw; pw.x = pk2(o0.x, o0.y); pw.y = pk2(o0.z, o0.w); pw.z = pk2(o1.x, o1.y); pw.w = pk2(o1.z, o1.w);
                    *(u32x4*)(out + off + bj * 128) = pw; } }
            __builtin_amdgcn_sched_barrier(0);
        }
    }
};
struct EpiF32 {
    static constexpr bool PERM = false, AFTER_DRAIN = false;
    float* O; int ldc;
    __device__ __forceinline__ void operator()(const f32x4 (&acc)[2][2][4][2], const pg8::Unit& u, int wr, int wc, int fr, int fq) const {
        const int row0 = u.pm * 256 + wr * 64 + fr, col0 = u.pn * 256 + wc * 32 + 4 * fq;
#pragma unroll
        for (int ai = 0; ai < 2; ++ai)
#pragma unroll
            for (int m = 0; m < 4; ++m) { const size_t off = (size_t)(row0 + ai * 128 + m * 16) * ldc + col0;
#pragma unroll
                for (int bj = 0; bj < 2; ++bj)
#pragma unroll
                    for (int n = 0; n < 2; ++n) *(f32x4*)(O + off + bj * 128 + n * 16) = acc[ai][bj][m][n]; }
    }
};

#ifndef MOE_FP8
#define MOE_FP8 1
#endif
#ifndef FFN_FP8
#define FFN_FP8 3
#endif
#define FFN8_GU ((FFN_FP8 & 1) != 0)
#define FFN8_DN ((FFN_FP8 & 2) != 0)
constexpr float F8_FD = 128.f;
constexpr float F8_WGU = 32.f, F8_WD = 128.f;
__device__ __forceinline__ unsigned pk4_fp8(float a, float b, float c, float d) { int p = __builtin_amdgcn_cvt_pk_fp8_f32(a, b, 0, false); p = __builtin_amdgcn_cvt_pk_fp8_f32(c, d, p, true); return (unsigned)p; }
struct EpiSwiglu8 {
    static constexpr bool PERM = true, AFTER_DRAIN = false;
    unsigned char* O; int ldc; float asc;
    __device__ __forceinline__ void operator()(const f32x4 (&acc)[2][2][4][2], const pg8::Unit& u, int wr, int wc, int fr, int fq) const {
        const int row0 = u.pm * 256 + wr * 64 + fr, col0 = u.pn * 128 + wc * 32 + 8 * fq;
#pragma unroll
        for (int ai = 0; ai < 2; ++ai)
#pragma unroll
            for (int m = 0; m < 4; ++m) { unsigned char* rowp = O + (size_t)(row0 + ai * 128 + m * 16) * ldc + col0;
                float o[8];
#pragma unroll
                for (int n = 0; n < 2; ++n)
#pragma unroll
                    for (int i = 0; i < 4; ++i) { const float g = acc[ai][0][m][n][i] * asc, up = acc[ai][1][m][n][i] * asc; o[n * 4 + i] = g * __builtin_amdgcn_rcpf(1.f + __expf(-g)) * up; }
                u32x2 w; w.x = pk4_fp8(o[0], o[1], o[2], o[3]); w.y = pk4_fp8(o[4], o[5], o[6], o[7]);
                *(u32x2*)rowp = w; }
    }
};
struct EpiBf16S {
    static constexpr bool PERM = false, AFTER_DRAIN = false;
    bf16* O; int ldc; float s;
    __device__ __forceinline__ void operator()(const f32x4 (&acc)[2][2][4][2], const pg8::Unit& u, int wr, int wc, int fr, int fq) const {
        const int row0 = u.pm * 256 + wr * 64 + fr, col0 = u.pn * 256 + wc * 32 + 4 * fq;
#pragma unroll
        for (int ai = 0; ai < 2; ++ai)
#pragma unroll
            for (int m = 0; m < 4; ++m) { const size_t off = (size_t)(row0 + ai * 128 + m * 16) * ldc + col0;
#pragma unroll
                for (int bj = 0; bj < 2; ++bj)
#pragma unroll
                    for (int n = 0; n < 2; ++n) { const f32x4 v = acc[ai][bj][m][n] * s; u32x2 w; w.x = pg8::cvt_pk_bf16(v[0], v[1]); w.y = pg8::cvt_pk_bf16(v[2], v[3]); *(u32x2*)(O + off + bj * 128 + n * 16) = w; } }
    }
};
struct EpiF32S {
    static constexpr bool PERM = false, AFTER_DRAIN = false;
    float* O; int ldc; float s;
    __device__ __forceinline__ void operator()(const f32x4 (&acc)[2][2][4][2], const pg8::Unit& u, int wr, int wc, int fr, int fq) const {
        const int row0 = u.pm * 256 + wr * 64 + fr, col0 = u.pn * 256 + wc * 32 + 4 * fq;
#pragma unroll
        for (int ai = 0; ai < 2; ++ai)
#pragma unroll
            for (int m = 0; m < 4; ++m) { const size_t off = (size_t)(row0 + ai * 128 + m * 16) * ldc + col0;
#pragma unroll
                for (int bj = 0; bj < 2; ++bj)
#pragma unroll
                    for (int n = 0; n < 2; ++n) *(f32x4*)(O + off + bj * 128 + n * 16) = acc[ai][bj][m][n] * s; }
    }
};
template <class RM> __device__ __forceinline__ void transpose_item_f8(const float* W, int K, int N, unsigned char* WT, int item, int lane, const RM& rm, float scale) {
    const int nblk = (N + 63) >> 6, kb = item / nblk, nb = item - kb * nblk, k0 = 64 * kb + 16 * (lane >> 4), n = 64 * nb + 4 * (lane & 15);
    if (n >= N) return;
    const float* src = W + (size_t)k0 * N + n;
    f32x4 v[16];
#pragma unroll
    for (int i = 0; i < 16; ++i) v[i] = *(const f32x4*)(src + (size_t)i * N) * scale;
#pragma unroll
    for (int j = 0; j < 4; ++j) { u32x4 o;
        o.x = pk4_fp8(v[0][j], v[1][j], v[2][j], v[3][j]); o.y = pk4_fp8(v[4][j], v[5][j], v[6][j], v[7][j]); o.z = pk4_fp8(v[8][j], v[9][j], v[10][j], v[11][j]); o.w = pk4_fp8(v[12][j], v[13][j], v[14][j], v[15][j]);
        *(u32x4*)(WT + (size_t)rm(n + j) * K + k0) = o; }
}
struct MoeOrder {
    int nP, nN, nU, G, c; int b1, b2, b3, b4, b5, b6, b7;
    __device__ __forceinline__ void init(const int* moe_base, int N, int G_, int c_) { nP = __builtin_amdgcn_readfirstlane(moe_base[8]) >> 8; nN = N / 256; nU = nP * nN; G = G_; c = c_;
        b1 = __builtin_amdgcn_readfirstlane(moe_base[1]); b2 = __builtin_amdgcn_readfirstlane(moe_base[2]); b3 = __builtin_amdgcn_readfirstlane(moe_base[3]); b4 = __builtin_amdgcn_readfirstlane(moe_base[4]);
        b5 = __builtin_amdgcn_readfirstlane(moe_base[5]); b6 = __builtin_amdgcn_readfirstlane(moe_base[6]); b7 = __builtin_amdgcn_readfirstlane(moe_base[7]); }
    __device__ __forceinline__ bool next(int i, pg8::Unit& u) const {
        const int L = i * G + c; if (L >= nU) return false;
        const int nig = 8 * nN, gid = L / nig, fm = gid * 8, gsz = (nP - fm) < 8 ? (nP - fm) : 8, r = L % nig;
        u.pm = fm + r % gsz; u.pn = r / gsz;
        const int row0 = u.pm * 256; const int e = (row0 >= b1) + (row0 >= b2) + (row0 >= b3) + (row0 >= b4) + (row0 >= b5) + (row0 >= b6) + (row0 >= b7);
        u.pb = e * nN + u.pn; return true;
    }
    __device__ __forceinline__ void a_ready(const pg8::Unit&) const {}
    __device__ __forceinline__ void done(const pg8::Unit&) const {}
};

template <class RM> __device__ __forceinline__ void transpose_item(const float* W, int K, int N, bf16* WT, LAS float*, int item, int lane, const RM& rm, int pitch = 0) {
    if (pitch == 0) pitch = K;
    const int nblk = (N + 63) >> 6, kb = item / nblk, nb = item - kb * nblk, k0 = 64 * kb + 16 * (lane >> 4), n = 64 * nb + 4 * (lane & 15);
    if (n >= N) return;
    const float* src = W + (size_t)k0 * N + n;
    f32x4 v[16];
#pragma unroll
    for (int i = 0; i < 16; ++i) v[i] = *(const f32x4*)(src + (size_t)i * N);
#pragma unroll
    for (int j = 0; j < 4; ++j) { bf16* dst = WT + (size_t)rm(n + j) * pitch + k0;
        u32x4 o0, o1;
        o0.x = pk2(v[0][j], v[1][j]); o0.y = pk2(v[2][j], v[3][j]); o0.z = pk2(v[4][j], v[5][j]); o0.w = pk2(v[6][j], v[7][j]);
        o1.x = pk2(v[8][j], v[9][j]); o1.y = pk2(v[10][j], v[11][j]); o1.z = pk2(v[12][j], v[13][j]); o1.w = pk2(v[14][j], v[15][j]);
        *(u32x4*)dst = o0; *(u32x4*)(dst + 8) = o1; }
}
__device__ __forceinline__ int inproj_dst_row(int s) {
    if (s < 2560) return s;
    if (s < 2584) return s + 3072;
    if (s < 4632) return s - 24;
    if (s < 4648) return s + 1024;
    return s - 40;
}
struct WItem { const float* src; unsigned char* dst; int N, K, k0, n, kind; bool f8, valid; float scale; };
__device__ __forceinline__ int witem_row(int kind, int n) {
    if (kind == 1) return inproj_dst_row(n);
    if (kind == 2) return ((n >> 7) << 8) + (n & 127);
    if (kind == 3) return ((n >> 7) << 8) + 128 + (n & 127);
    return n;
}
__device__ __forceinline__ void witem_load(const WItem& w, f32x4 (&v)[16]) {
    if (!w.valid) return;
#pragma unroll
    for (int i = 0; i < 16; ++i) v[i] = *(const f32x4*)(w.src + (size_t)i * w.N);
}
__device__ __forceinline__ void witem_store(const WItem& w, const f32x4 (&v)[16]) {
    if (!w.valid) return;
    if (w.f8) {
#pragma unroll
        for (int j = 0; j < 4; ++j) { u32x4 o; const float sc = w.scale;
            o.x = pk4_fp8(v[0][j] * sc, v[1][j] * sc, v[2][j] * sc, v[3][j] * sc); o.y = pk4_fp8(v[4][j] * sc, v[5][j] * sc, v[6][j] * sc, v[7][j] * sc);
            o.z = pk4_fp8(v[8][j] * sc, v[9][j] * sc, v[10][j] * sc, v[11][j] * sc); o.w = pk4_fp8(v[12][j] * sc, v[13][j] * sc, v[14][j] * sc, v[15][j] * sc);
            *(u32x4*)(w.dst + (size_t)witem_row(w.kind, w.n + j) * w.K + w.k0) = o; }
    } else {
#pragma unroll
        for (int j = 0; j < 4; ++j) { bf16* dst = (bf16*)w.dst + (size_t)witem_row(w.kind, w.n + j) * w.K + w.k0;
            u32x4 o0, o1;
            o0.x = pk2(v[0][j], v[1][j]); o0.y = pk2(v[2][j], v[3][j]); o0.z = pk2(v[4][j], v[5][j]); o0.w = pk2(v[6][j], v[7][j]);
            o1.x = pk2(v[8][j], v[9][j]); o1.y = pk2(v[10][j], v[11][j]); o1.z = pk2(v[12][j], v[13][j]); o1.w = pk2(v[14][j], v[15][j]);
            *(u32x4*)dst = o0; *(u32x4*)(dst + 8) = o1; }
    }
}
__device__ __forceinline__ void p0_weights(const Args& a, LAS unsigned char* lds) {
    const int lane = threadIdx.x & 63, wave = __builtin_amdgcn_readfirstlane(threadIdx.x >> 6);
    const int gw = blockIdx.x * 8 + wave, NGW = gridDim.x * 8;
    constexpr int I_IN = 16 * 178, I_OUT = 16 * 64, I_FG = 16 * 176, I_FD = 44 * 64, I_MG = 16 * 224, I_MD = 56 * 64;
    constexpr int NIT = 2 * I_IN + 2 * I_OUT + 2 * I_FG + I_FD + 16 * I_MG + 8 * I_MD;
    auto decode = [&](int it) -> WItem {
        WItem w; w.valid = false; w.src = nullptr; w.dst = nullptr; w.N = 0; w.K = 0; w.k0 = 0; w.n = 0; w.kind = 0; w.f8 = false; w.scale = 1.f;
        if (it >= NIT) return w;
        int r = it; const float* W;
        if (r < 2 * I_IN) { const int l = r / I_IN; r -= l * I_IN; W = a.in[I_WIN] + (size_t)l * D * INW; w.K = D; w.N = INW; w.dst = a.ws + WS_WIN_T + (size_t)l * PW * D * 2; w.kind = 1; }
        else if ((r -= 2 * I_IN) < 2 * I_OUT) { const int l = r / I_OUT; r -= l * I_OUT; W = a.in[I_WOUT] + (size_t)l * D * D; w.K = D; w.N = D; w.dst = a.ws + WS_WOUT_T + (size_t)l * D * D * 2; }
        else if ((r -= 2 * I_OUT) < 2 * I_FG) { const int up = r / I_FG; r -= up * I_FG; W = a.in[up ? I_FWU : I_FWG]; w.K = D; w.N = DFF; w.dst = a.ws + WS_FGU_T; w.kind = 2 + up; w.f8 = FFN8_GU; w.scale = F8_WGU; }
        else if ((r -= 2 * I_FG) < I_FD) { W = a.in[I_FWD]; w.K = DFF; w.N = D; w.dst = a.ws + WS_FD_T; w.f8 = FFN8_DN; w.scale = F8_FD; }
        else if ((r -= I_FD) < 16 * I_MG) { const int up = r / (8 * I_MG); r -= up * 8 * I_MG; const int e = r / I_MG; r -= e * I_MG; W = a.in[up ? I_MWU : I_MWG] + (size_t)e * D * DFE; w.K = D; w.N = DFE;
            w.dst = a.ws + WS_MGU_T + (size_t)e * 2 * DFE * D * (MOE_FP8 ? 1 : 2); w.kind = 2 + up; w.f8 = MOE_FP8; w.scale = F8_WGU; }
        else { r -= 16 * I_MG; const int e = r / I_MD; r -= e * I_MD; W = a.in[I_MWD] + (size_t)e * DFE * D; w.K = DFE; w.N = D; w.dst = a.ws + WS_MD_T + (size_t)e * D * DFE * (MOE_FP8 ? 1 : 2); w.f8 = MOE_FP8; w.scale = F8_WD; }
        const int nblk = (w.N + 31) >> 5, kb = r / nblk, nb = r - kb * nblk;
        w.k0 = 128 * kb + 16 * (lane >> 3); w.n = 32 * nb + 4 * (lane & 7); w.valid = w.n < w.N; w.src = W + (size_t)w.k0 * w.N + w.n;
        return w;
    };
    { f32x4 v[16], vn[16];
      WItem cur = decode(gw); witem_load(cur, v);
#pragma unroll 1
      for (int it = gw; it < NIT; it += NGW) {
          const WItem nxt = decode(it + NGW); witem_load(nxt, vn);
          __builtin_amdgcn_sched_barrier(0);
          witem_store(cur, v);
          __builtin_amdgcn_sched_barrier(0);
#pragma unroll
          for (int i = 0; i < 16; ++i) v[i] = vn[i];
          cur = nxt; } }
    for (int idx = blockIdx.x * 512 + threadIdx.x; idx < 2 * (PW - INW) * D / 8; idx += gridDim.x * 512) {
        const int l = idx / ((PW - INW) * D / 8), r = idx - l * ((PW - INW) * D / 8);
        *(u32x4*)((bf16*)(a.ws + WS_WIN_T) + (size_t)l * PW * D + (size_t)INW * D + (size_t)r * 8) = (u32x4){0u, 0u, 0u, 0u};
    }
}
__device__ __forceinline__ void p_mod_rows(const Args& a, const float* X, const float* modsh, const float* modsc) {
    const int lane = threadIdx.x & 63, wave = __builtin_amdgcn_readfirstlane(threadIdx.x >> 6);
    bf16* HB = (bf16*)(a.ws + WS_HB);
    const int gw = blockIdx.x * 8 + wave, NGW = gridDim.x * 8;
    f32x4 v[8], vn[8];
    if (gw < M) {
#pragma unroll
        for (int j = 0; j < 8; ++j) v[j] = *(const f32x4*)(X + (size_t)gw * D + j * 256 + lane * 4); }
#pragma unroll 1
    for (int m = gw; m < M; m += NGW) { const size_t bo = (size_t)(m >> 12) * D6; const int mn = m + NGW;
        if (mn < M) {
#pragma unroll
            for (int j = 0; j < 8; ++j) vn[j] = *(const f32x4*)(X + (size_t)mn * D + j * 256 + lane * 4); }
        f32x4 shv[8], scv[8];
#pragma unroll
        for (int j = 0; j < 8; ++j) { const int k = j * 256 + lane * 4; shv[j] = *(const f32x4*)(modsh + bo + k); scv[j] = *(const f32x4*)(modsc + bo + k); }
        __builtin_amdgcn_sched_barrier(0);
#pragma unroll
        for (int j = 0; j < 8; ++j) st_bf4(HB + (size_t)m * D + j * 256 + lane * 4, v[j] * (1.f + scv[j]) + shv[j]);
        __builtin_amdgcn_sched_barrier(0);
#pragma unroll
        for (int j = 0; j < 8; ++j) v[j] = vn[j]; }
}

template <bool DUAL, class AL, class BL, class EP>
__device__ __forceinline__ void ggemm_tile(LAS float* lds, int m0, int n0, int K, const AL& al, const BL& bl, const EP& ep) {
    LAS float* As = lds; LAS float* Bs = lds + 16 * 132; LAS float* Bs2 = Bs + 16 * 128;
    const int tid = threadIdx.x, ty = tid >> 5, tx = tid & 31;
    const int ar = tid >> 2, ak = (tid & 3) * 4, bk = tid >> 5, bn = (tid & 31) * 4;
    f32x4 acc[8], acc2[8];
#pragma unroll
    for (int i = 0; i < 8; ++i) { acc[i] = (f32x4){0.f, 0.f, 0.f, 0.f}; acc2[i] = (f32x4){0.f, 0.f, 0.f, 0.f}; }
    f32x4 a = al(m0 + ar, ak), b = bl(bk, n0 + bn, 0), b2 = (f32x4){0.f, 0.f, 0.f, 0.f};
    if (DUAL) b2 = bl(bk, n0 + bn, 1);
    for (int k0 = 0; k0 < K; k0 += 16) {
        __syncthreads();
        As[(ak + 0) * 132 + ar] = a.x; As[(ak + 1) * 132 + ar] = a.y; As[(ak + 2) * 132 + ar] = a.z; As[(ak + 3) * 132 + ar] = a.w;
        *(LAS f32x4*)(Bs + bk * 128 + bn) = b;
        if (DUAL) *(LAS f32x4*)(Bs2 + bk * 128 + bn) = b2;
        __syncthreads();
        if (k0 + 16 < K) { a = al(m0 + ar, k0 + 16 + ak); b = bl(k0 + 16 + bk, n0 + bn, 0); if (DUAL) b2 = bl(k0 + 16 + bk, n0 + bn, 1); }
#pragma unroll
        for (int kk = 0; kk < 16; ++kk) {
            const f32x4 a0 = *(const LAS f32x4*)(As + kk * 132 + ty * 8), a1 = *(const LAS f32x4*)(As + kk * 132 + ty * 8 + 4);
            const f32x4 bv = *(const LAS f32x4*)(Bs + kk * 128 + tx * 4);
            acc[0] += a0.x * bv; acc[1] += a0.y * bv; acc[2] += a0.z * bv; acc[3] += a0.w * bv;
            acc[4] += a1.x * bv; acc[5] += a1.y * bv; acc[6] += a1.z * bv; acc[7] += a1.w * bv;
            if (DUAL) {
                const f32x4 bw = *(const LAS f32x4*)(Bs2 + kk * 128 + tx * 4);
                acc2[0] += a0.x * bw; acc2[1] += a0.y * bw; acc2[2] += a0.z * bw; acc2[3] += a0.w * bw;
                acc2[4] += a1.x * bw; acc2[5] += a1.y * bw; acc2[6] += a1.z * bw; acc2[7] += a1.w * bw;
            }
        }
    }
#pragma unroll
    for (int i = 0; i < 8; ++i) ep(m0 + ty * 8 + i, n0 + tx * 4, acc[i], acc2[i]);
}


__device__ __forceinline__ int vperm16(int k) { return (k & 3) + ((k & 8) >> 1) + ((k & 4) << 1); }
__device__ __forceinline__ int inproj_src_col(int n) {
    if (n < 2560) return n;
    if (n < 4608) return n + 24;
    if (n < 5632) return n + 40;
    if (n < 5656) return n - 3072;
    if (n < 5672) return n - 1024;
    return -1;
}

__device__ __forceinline__ void p0_mod(const Args& a, LAS unsigned char* lds) {
    LAS float* scl = (LAS float*)lds;
    LAS float* red = scl + 4 * 2048;
    const int tid = threadIdx.x;
    const float* c = a.in[I_C];
    for (int i = tid; i < 4 * 2048; i += 512) scl[i] = siluf_(c[i]);
    __syncthreads();
    float* mod = (float*)(a.ws + WS_MOD);
    const int cq = tid & 31, ks = tid >> 5;
    for (int item = blockIdx.x; item < 192; item += gridDim.x) {
        const int l = item / 96, col0 = (item % 96) * 128;
        const float* w = a.in[I_WADA] + (size_t)l * D * D6 + col0 + cq * 4;
        f32x4 acc[4];
#pragma unroll
        for (int b = 0; b < 4; ++b) acc[b] = (f32x4){0.f, 0.f, 0.f, 0.f};
#pragma unroll 1
        for (int k0 = 0; k0 < 128; k0 += 32) {
            f32x4 wv[32];
#pragma unroll
            for (int kk = 0; kk < 32; ++kk) wv[kk] = *(const f32x4*)(w + (size_t)(ks * 128 + k0 + kk) * D6);
            __builtin_amdgcn_sched_barrier(0);
#pragma unroll
            for (int kk = 0; kk < 32; ++kk) { const int k = ks * 128 + k0 + kk;
#pragma unroll
                for (int b = 0; b < 4; ++b) acc[b] += scl[b * 2048 + k] * wv[kk]; }
            __builtin_amdgcn_sched_barrier(0);
        }
        __syncthreads();
#pragma unroll
        for (int b = 0; b < 4; ++b) *(LAS f32x4*)(red + ks * 512 + b * 128 + cq * 4) = acc[b];
        __syncthreads();
        { const int b = tid >> 7, cc = tid & 127; float s = 0.f;
#pragma unroll
          for (int k2 = 0; k2 < 16; ++k2) s += red[k2 * 512 + tid];
          mod[(size_t)(l * 4 + b) * D6 + col0 + cc] = s + a.in[I_BADA][(size_t)l * D6 + col0 + cc]; }
    }
    const double INVREV[16] = {0.15915494309189535, 0.0700865215877985, 0.03086376340470123, 0.013591370636193905, 0.005985185712713705, 0.002635675898667414, 0.001160663641240061, 0.0005111175045375439,
                               0.00022507907903927653, 9.911730936901935e-05, 4.364795279280289e-05, 1.9221100684944863e-05, 8.464330808241401e-06, 3.727408601915352e-06, 1.6414262627950345e-06, 7.228293068832865e-07};
    float* rope = (float*)(a.ws + WS_ROPE);
    for (int idx = blockIdx.x * 512 + tid; idx < 4096 * 16; idx += gridDim.x * 512) {
        const int t = idx >> 4, i = idx & 15;
        double inv = INVREV[0];
#pragma unroll
        for (int j = 1; j < 16; ++j) inv = (i == j) ? INVREV[j] : inv;
        const double rev = (double)t * inv; const float fr = (float)(rev - __builtin_floor(rev));
        rope[t * 32 + i] = __builtin_amdgcn_cosf(fr); rope[t * 32 + 16 + i] = __builtin_amdgcn_sinf(fr);
    }
}

template <int L> __device__ __forceinline__ void p_inproj_g(const Args& a, LAS unsigned char* lds, const float* xin) {
    const float* mod = (const float*)(a.ws + WS_MOD) + (size_t)L * 4 * D6;
    const float* W = a.in[I_WIN] + (size_t)L * D * INW;
    bf16* proj = (bf16*)(a.ws + WS_PROJ);
    auto al = [&](int m, int k) -> f32x4 { const float* md = mod + (size_t)(m >> 12) * D6; const f32x4 x = *(const f32x4*)(xin + (size_t)m * D + k);
        const f32x4 sh = *(const f32x4*)(md + k), sc = *(const f32x4*)(md + 2048 + k); return x * (1.f + sc) + sh; };
    auto bl = [&](int k, int n, int) -> f32x4 { const int s = inproj_src_col(n); if (s < 0) return (f32x4){0.f, 0.f, 0.f, 0.f}; return *(const f32x4*)(W + (size_t)k * INW + s); };
    auto ep = [&](int m, int n, f32x4 v, f32x4) { st_bf4(proj + (size_t)m * PW + n, v); };
    for (int t = blockIdx.x; t < (M / 128) * (PW / 128); t += gridDim.x) { const int tm = t / (PW / 128), tn = t % (PW / 128);
        ggemm_tile<false>((LAS float*)lds, tm * 128, tn * 128, D, al, bl, ep); }
}

template <int L> __device__ __forceinline__ void p_cmp1_g(const Args& a, LAS unsigned char* lds) {
    bf16* proj = (bf16*)(a.ws + WS_PROJ);
    float* chid = (float*)(a.ws + WS_CHID);
    for (int t = blockIdx.x; t < 2 * 16 * 2; t += gridDim.x) {
        const int kind = t >> 5, tm = (t >> 1) & 15, tn = t & 1;
        const float* pe = a.in[kind ? I_CPV : I_CPK] + (size_t)L * 32 * 128;
        const float* W1 = a.in[kind ? I_CW1V : I_CW1K] + (size_t)L * 4096 * 256;
        const int coff = kind ? PVC : PKC;
        auto al = [&](int r, int k) -> f32x4 { const int c = r & 255, bh = r >> 8, b = bh >> 1, h = bh & 1; if (c >= 255) return (f32x4){0.f, 0.f, 0.f, 0.f};
            const int l = k >> 7, d = k & 127; const f32x4 v = ld_bf4(proj + (size_t)(b * T + 16 * c + l) * PW + coff + h * 128 + d); return v + *(const f32x4*)(pe + l * 128 + d); };
        auto bl = [&](int k, int n, int) -> f32x4 { return *(const f32x4*)(W1 + (size_t)k * 256 + n); };
        auto ep = [&](int r, int n, f32x4 v, f32x4) { f32x4 o; o.x = gelu_tanh(v.x); o.y = gelu_tanh(v.y); o.z = gelu_tanh(v.z); o.w = gelu_tanh(v.w); *(f32x4*)(chid + ((size_t)kind * NCR + r) * 256 + n) = o; };
        ggemm_tile<false>((LAS float*)lds, tm * 128, tn * 128, 4096, al, bl, ep);
    }
    const float* rope = (const float*)(a.ws + WS_ROPE);
    const int gt = blockIdx.x * 512 + threadIdx.x, NGT = gridDim.x * 512;
    for (int idx = gt; idx < M * 64; idx += NGT) {
        const int i = idx & 15, hh = (idx >> 4) & 1, ts = (idx >> 5) & 1, m = idx >> 6, t = m & (T - 1);
        bf16* p = proj + (size_t)m * PW + (ts ? PKW : PKS) + hh * 128 + i;
        const float x1 = bf1(p[0]), x2 = bf1(p[16]), c = rope[t * 32 + i], s = rope[t * 32 + 16 + i];
        p[0] = (bf16)f2bf(x1 * c - x2 * s); p[16] = (bf16)f2bf(x2 * c + x1 * s);
    }
    float* LA = (float*)(a.ws + WS_LA);
    const float* wa2 = a.in[I_GWA2] + (size_t)L * 16 * 512; const float* ba = a.in[I_GBA] + (size_t)L * 512;
    for (int idx = gt; idx < M * 512; idx += NGT) {
        const int hd = idx & 511, m = idx >> 9; const bf16* ga = proj + (size_t)m * PW + PGA;
        float z = ba[hd];
#pragma unroll
        for (int r = 0; r < 16; ++r) z += bf1(ga[r]) * wa2[r * 512 + hd];
        const float ls = fminf(z, 0.f) - log1pf(__expf(-fabsf(z)));
        LA[idx] = ls * (1.f / 16.f);
    }
}
template <int L> __device__ __forceinline__ void p_cmp2_g(const Args& a, LAS unsigned char* lds) {
    const float* chid = (const float*)(a.ws + WS_CHID); float* KC = (float*)(a.ws + WS_KC);
    for (int t = blockIdx.x; t < 2 * 16; t += gridDim.x) {
        const int kind = t >> 4, tm = t & 15;
        const float* W2 = a.in[kind ? I_CW2V : I_CW2K] + (size_t)L * 256 * 128;
        auto al = [&](int r, int k) -> f32x4 { return *(const f32x4*)(chid + ((size_t)kind * NCR + r) * 256 + k); };
        auto bl = [&](int k, int n, int) -> f32x4 { return *(const f32x4*)(W2 + (size_t)k * 128 + n); };
        bf16* KCB = (bf16*)(a.ws + WS_KCB); bf16* VCT = (bf16*)(a.ws + WS_VCT);
        auto ep = [&](int r, int n, f32x4 v, f32x4) { *(f32x4*)(KC + ((size_t)kind * NCR + r) * 128 + n) = v;
            if (kind == 0) st_bf4(KCB + (size_t)r * 128 + n, v);
            else { bf16* vp = VCT + (size_t)((r >> 8) * 128 + n) * 256 + (r & 240) + vperm16(r & 15); vp[0] = (bf16)f2bf(v.x); vp[256] = (bf16)f2bf(v.y); vp[512] = (bf16)f2bf(v.z); vp[768] = (bf16)f2bf(v.w); } };
        ggemm_tile<false>((LAS float*)lds, tm * 128, 0, 256, al, bl, ep);
    }
}

__device__ __forceinline__ void dot4_bf(const bf16* kr, const LAS float* qs, float& s0, float& s1, float& s2, float& s3) {
    s0 = s1 = s2 = s3 = 0.f;
#pragma unroll 4
    for (int d8 = 0; d8 < 16; ++d8) {
        const u32x4 raw = *(const u32x4*)(kr + d8 * 8);
        const float kv[8] = {bflo(raw.x), bfhi(raw.x), bflo(raw.y), bfhi(raw.y), bflo(raw.z), bfhi(raw.z), bflo(raw.w), bfhi(raw.w)};
#pragma unroll
        for (int hf = 0; hf < 2; ++hf) {
            const f32x4 q0 = *(const LAS f32x4*)(qs + d8 * 8 + hf * 4), q1 = *(const LAS f32x4*)(qs + 128 + d8 * 8 + hf * 4), q2 = *(const LAS f32x4*)(qs + 256 + d8 * 8 + hf * 4), q3 = *(const LAS f32x4*)(qs + 384 + d8 * 8 + hf * 4);
            const float k0 = kv[hf * 4], k1 = kv[hf * 4 + 1], k2 = kv[hf * 4 + 2], k3 = kv[hf * 4 + 3];
            s0 += k0 * q0.x + k1 * q0.y + k2 * q0.z + k3 * q0.w; s1 += k0 * q1.x + k1 * q1.y + k2 * q1.z + k3 * q1.w;
            s2 += k0 * q2.x + k1 * q2.y + k2 * q2.z + k3 * q2.w; s3 += k0 * q3.x + k1 * q3.y + k2 * q3.z + k3 * q3.w;
        }
    }
}
__device__ __forceinline__ void dot4_f32(const float* kr, const LAS float* qs, float& s0, float& s1, float& s2, float& s3) {
    s0 = s1 = s2 = s3 = 0.f;
#pragma unroll 4
    for (int d4 = 0; d4 < 32; ++d4) {
        const f32x4 k = *(const f32x4*)(kr + d4 * 4);
        const f32x4 q0 = *(const LAS f32x4*)(qs + d4 * 4), q1 = *(const LAS f32x4*)(qs + 128 + d4 * 4), q2 = *(const LAS f32x4*)(qs + 256 + d4 * 4), q3 = *(const LAS f32x4*)(qs + 384 + d4 * 4);
        s0 += k.x * q0.x + k.y * q0.y + k.z * q0.z + k.w * q0.w; s1 += k.x * q1.x + k.y * q1.y + k.z * q1.z + k.w * q1.w;
        s2 += k.x * q2.x + k.y * q2.y + k.z * q2.z + k.w * q2.w; s3 += k.x * q3.x + k.y * q3.y + k.z * q3.z + k.w * q3.w;
    }
}
__device__ __forceinline__ void wave_softmax4(LAS float* sc, int nent, int lane) {
#pragma unroll
    for (int g = 0; g < 4; ++g) {
        LAS float* r = sc + g * 1024;
        float mx = -INFINITY;
        for (int i = lane; i < nent; i += 64) mx = fmaxf(mx, r[i]);
        mx = wave_max(mx);
        float sum = 0.f;
        for (int i = lane; i < nent; i += 64) { const float e = __expf(r[i] - mx); r[i] = e; sum += e; }
        sum = wave_sum(sum);
        const float inv = 1.f / sum;
        for (int i = lane; i < nent; i += 64) r[i] *= inv;
    }
}
__device__ __forceinline__ void p_nsa_g(const Args& a, LAS unsigned char* lds) {
    const int lane_ = threadIdx.x & 63, wave = __builtin_amdgcn_readfirstlane(threadIdx.x >> 6);
    LAS float* sc = (LAS float*)(lds + wave * 18432);
    LAS float* qs = sc + 4096;
    const bf16* proj = (const bf16*)(a.ws + WS_PROJ);
    const float* KC = (const float*)(a.ws + WS_KC);
    const float* rope = (const float*)(a.ws + WS_ROPE);
    bf16* mix = (bf16*)(a.ws + WS_MIX);
    const int gw = blockIdx.x * 8 + wave, NGW = gridDim.x * 8;
    for (int u = gw; u < NB * T * 2; u += NGW) {
        const int h = u & 1, t = (u >> 1) & (T - 1), b = u >> 13, m = b * T + t;
        int lane = lane_; asm volatile("" : "+v"(lane));
        const bf16* prow = proj + (size_t)m * PW;
        float qv[8];
        { const u32x4 raw = *(const u32x4*)(prow + PQ + h * 512 + lane * 8);
          qv[0] = bflo(raw.x); qv[1] = bfhi(raw.x); qv[2] = bflo(raw.y); qv[3] = bfhi(raw.y); qv[4] = bflo(raw.z); qv[5] = bfhi(raw.z); qv[6] = bflo(raw.w); qv[7] = bfhi(raw.w); }
#pragma unroll
        for (int i = 0; i < 8; ++i) qs[lane * 8 + i] = qv[i] * QSCALE;
        const int ncv = (t >= 31) ? ((t - 31) >> 4) + 1 : 0;
        const float* kcb = KC + (size_t)((b * 2 + h) * 256) * 128; const float* vcb = kcb + (size_t)NCR * 128;
        float oc[4][2] = {{0.f, 0.f}, {0.f, 0.f}, {0.f, 0.f}, {0.f, 0.f}};
        if (ncv > 0) {
#pragma unroll
            for (int j = 0; j < 4; ++j) { const int c = lane + 64 * j; float s0 = -INFINITY, s1 = -INFINITY, s2 = -INFINITY, s3 = -INFINITY;
                if (c < ncv) dot4_f32(kcb + (size_t)c * 128, qs, s0, s1, s2, s3);
                sc[c] = s0; sc[1024 + c] = s1; sc[2048 + c] = s2; sc[3072 + c] = s3; }
            wave_softmax4(sc, 256, lane);
            for (int c = 0; c < ncv; ++c) { const f32x2 v = *(const f32x2*)(vcb + (size_t)c * 128 + 2 * lane);
#pragma unroll
                for (int g = 0; g < 4; ++g) { const float p = sc[g * 1024 + c]; oc[g][0] += p * v.x; oc[g][1] += p * v.y; } }
        } else {
#pragma unroll
            for (int j = 0; j < 4; ++j) { const int c = lane + 64 * j; sc[c] = 0.f; sc[1024 + c] = 0.f; sc[2048 + c] = 0.f; sc[3072 + c] = 0.f; }
        }
        unsigned long long sel;
        { const int n = lane, cur = t >> 6; float imp = 0.f;
#pragma unroll
          for (int g = 0; g < 4; ++g)
#pragma unroll
              for (int cc = -1; cc < 4; ++cc) { const int c = 4 * n + cc; if (c >= 0 && c < 255) imp += sc[g * 1024 + c]; }
          const float iv = (n > cur) ? -INFINITY : ((n == 0 || n == cur || n == cur - 1) ? 1e9f : imp);
          int rank = 0;
          for (int m2 = 0; m2 < 64; ++m2) { const float v = __shfl(iv, m2); rank += ((v > iv) || (v == iv && m2 < n)) ? 1 : 0; }
          sel = __ballot(rank < 16); }
        { const int l16 = lane & 15; float part[8];
#pragma unroll
          for (int i = 0; i < 8; ++i) part[i] = __shfl_xor(qv[i], 2);
          if (l16 < 4) { const int ib = (l16 & 1) * 8; const bool lo = l16 < 2;
#pragma unroll
              for (int i = 0; i < 8; ++i) { const float c = rope[t * 32 + ib + i], s = rope[t * 32 + 16 + ib + i]; qv[i] = lo ? (qv[i] * c - part[i] * s) : (qv[i] * c + part[i] * s); } }
#pragma unroll
          for (int i = 0; i < 8; ++i) qs[lane * 8 + i] = qv[i] * QSCALE; }
        float os[4][2] = {{0.f, 0.f}, {0.f, 0.f}, {0.f, 0.f}, {0.f, 0.f}};
        { unsigned long long rem = sel; int jj = 0;
          while (rem) { const int n = __builtin_ctzll(rem); rem &= rem - 1; const int key = n * 64 + lane;
              float s0 = -INFINITY, s1 = -INFINITY, s2 = -INFINITY, s3 = -INFINITY;
              if (key <= t) dot4_bf(proj + (size_t)(b * T + key) * PW + PKS + h * 128, qs, s0, s1, s2, s3);
              sc[jj * 64 + lane] = s0; sc[1024 + jj * 64 + lane] = s1; sc[2048 + jj * 64 + lane] = s2; sc[3072 + jj * 64 + lane] = s3; ++jj; }
          wave_softmax4(sc, jj * 64, lane);
          rem = sel; jj = 0;
          while (rem) { const int n = __builtin_ctzll(rem); rem &= rem - 1;
              const int kmax = min(63, t - n * 64);
              for (int i = 0; i <= kmax; ++i) { const unsigned vw = *(const unsigned*)(proj + (size_t)(b * T + n * 64 + i) * PW + PVS + h * 128 + 2 * lane); const float v0 = bflo(vw), v1 = bfhi(vw);
#pragma unroll
                  for (int g = 0; g < 4; ++g) { const float p = sc[g * 1024 + jj * 64 + i]; os[g][0] += p * v0; os[g][1] += p * v1; } }
              ++jj; } }
        float ow[4][2] = {{0.f, 0.f}, {0.f, 0.f}, {0.f, 0.f}, {0.f, 0.f}};
        { const int t0 = max(0, t - 511), nk = t - t0 + 1, nb64 = (nk + 63) >> 6;
          for (int j = 0; j < nb64; ++j) { const int i = j * 64 + lane; float s0 = -INFINITY, s1 = -INFINITY, s2 = -INFINITY, s3 = -INFINITY;
              if (i < nk) dot4_bf(proj + (size_t)(b * T + t0 + i) * PW + PKW + h * 128, qs, s0, s1, s2, s3);
              sc[i] = s0; sc[1024 + i] = s1; sc[2048 + i] = s2; sc[3072 + i] = s3; }
          wave_softmax4(sc, nb64 * 64, lane);
          for (int i = 0; i < nk; ++i) { const unsigned vw = *(const unsigned*)(proj + (size_t)(b * T + t0 + i) * PW + PVW + h * 128 + 2 * lane); const float v0 = bflo(vw), v1 = bfhi(vw);
#pragma unroll
              for (int g = 0; g < 4; ++g) { const float p = sc[g * 1024 + i]; ow[g][0] += p * v0; ow[g][1] += p * v1; } } }
#pragma unroll
        for (int g = 0; g < 4; ++g) { const bf16* gp = prow + PNG + (h * 4 + g) * 3; const float g0 = sigmoidf_(bf1(gp[0])), g1 = sigmoidf_(bf1(gp[1])), g2 = sigmoidf_(bf1(gp[2]));
            const float o0 = g0 * oc[g][0] + g1 * os[g][0] + g2 * ow[g][0], o1 = g0 * oc[g][1] + g1 * os[g][1] + g2 * ow[g][1];
            *(unsigned*)(mix + (size_t)m * 2048 + (h * 4 + g) * 128 + 2 * lane) = pk2(o0, o1); }
    }
}

__device__ __forceinline__ void p_gla_g(const Args& a) {
    const int lane = threadIdx.x & 63, wave = __builtin_amdgcn_readfirstlane(threadIdx.x >> 6);
    const bf16* proj = (const bf16*)(a.ws + WS_PROJ); const float* LA = (const float*)(a.ws + WS_LA); float* glao = (float*)(a.ws + WS_GLAO);
    const int gw = blockIdx.x * 8 + wave, NGW = gridDim.x * 8;
    for (int u = gw; u < 2048; u += NGW) {
        const int e0 = (u & 127) * 2, h = (u >> 7) & 3, b = u >> 9;
        float S00 = 0.f, S01 = 0.f, S10 = 0.f, S11 = 0.f;
#pragma unroll 1
        for (int t0 = 0; t0 < T; t0 += 8) {
            float q0[8], q1[8], k0[8], k1[8], a0[8], a1[8]; unsigned vv[8];
#pragma unroll
            for (int s = 0; s < 8; ++s) { const size_t m = (size_t)b * T + t0 + s; const bf16* pr = proj + m * PW;
                q0[s] = bf1(pr[PGQ + h * 128 + lane]); q1[s] = bf1(pr[PGQ + h * 128 + 64 + lane]); k0[s] = bf1(pr[PGK + h * 128 + lane]); k1[s] = bf1(pr[PGK + h * 128 + 64 + lane]);
                a0[s] = LA[m * 512 + h * 128 + lane]; a1[s] = LA[m * 512 + h * 128 + 64 + lane]; vv[s] = *(const unsigned*)(pr + PGV + h * 256 + e0); }
            float r0[8], r1[8];
#pragma unroll
            for (int s = 0; s < 8; ++s) { const float d0 = __expf(a0[s]), d1 = __expf(a1[s]), v0 = bflo(vv[s]), v1 = bfhi(vv[s]);
                S00 = d0 * S00 + k0[s] * v0; S01 = d0 * S01 + k0[s] * v1; S10 = d1 * S10 + k1[s] * v0; S11 = d1 * S11 + k1[s] * v1;
                r0[s] = q0[s] * S00 + q1[s] * S10; r1[s] = q0[s] * S01 + q1[s] * S11; }
#pragma unroll
            for (int s = 0; s < 8; ++s) { r0[s] = wave_sum(r0[s]); r1[s] = wave_sum(r1[s]); }
#pragma unroll
            for (int s = 0; s < 8; ++s) if (lane == s) { f32x2 o; o.x = r0[s] * QSCALE; o.y = r1[s] * QSCALE; *(f32x2*)(glao + ((size_t)b * T + t0 + s) * 1024 + h * 256 + e0) = o; }
        }
    }
}
template <int L> __device__ __forceinline__ void p_glapost(const Args& a) {
    const int lane = threadIdx.x & 63, wave = __builtin_amdgcn_readfirstlane(threadIdx.x >> 6);
    const bf16* proj = (const bf16*)(a.ws + WS_PROJ); const float* glao = (const float*)(a.ws + WS_GLAO); bf16* mix = (bf16*)(a.ws + WS_MIX);
    const float* nw = a.in[I_GNW] + (size_t)L * 256;
    const int gw = blockIdx.x * 8 + wave, NGW = gridDim.x * 8;
    const f32x4 w4 = *(const f32x4*)(nw + lane * 4);
    for (int u = gw; u < M * 4; u += NGW) {
        const int h = u & 3, m = u >> 2;
        const f32x4 o = *(const f32x4*)(glao + (size_t)m * 1024 + h * 256 + lane * 4);
        const float ss = wave_sum(o.x * o.x + o.y * o.y + o.z * o.z + o.w * o.w);
        const float r = 1.f / sqrtf(ss * (1.f / 256.f) + NORM_EPS);
        const f32x4 gg = ld_bf4(proj + (size_t)m * PW + PGG + h * 256 + lane * 4);
        f32x4 y; y.x = o.x * r * w4.x * siluf_(gg.x); y.y = o.y * r * w4.y * siluf_(gg.y); y.z = o.z * r * w4.z * siluf_(gg.z); y.w = o.w * r * w4.w * siluf_(gg.w);
        st_bf4(mix + (size_t)m * 2048 + 1024 + h * 256 + lane * 4, y);
    }
}
template <int L> __device__ __forceinline__ void p_outproj_g(const Args& a, LAS unsigned char* lds, const float* xin, float* xout) {
    const float* mod = (const float*)(a.ws + WS_MOD) + (size_t)L * 4 * D6;
    const float* W = a.in[I_WOUT] + (size_t)L * 2048 * D; const bf16* mix = (const bf16*)(a.ws + WS_MIX);
    auto al = [&](int m, int k) -> f32x4 { return ld_bf4(mix + (size_t)m * 2048 + k); };
    auto bl = [&](int k, int n, int) -> f32x4 { return *(const f32x4*)(W + (size_t)k * D + n); };
    auto ep = [&](int m, int n, f32x4 v, f32x4) { const f32x4 g = *(const f32x4*)(mod + (size_t)(m >> 12) * D6 + 4096 + n); const f32x4 x = *(const f32x4*)(xin + (size_t)m * D + n);
        *(f32x4*)(xout + (size_t)m * D + n) = ALPHA * x + (1.f + g) * v; };
    for (int t = blockIdx.x; t < (M / 128) * (D / 128); t += gridDim.x) { const int tm = t >> 4, tn = t & 15; ggemm_tile<false>((LAS float*)lds, tm * 128, tn * 128, 2048, al, bl, ep); }
}
__device__ __forceinline__ void ln_regs(f32x4 (&v)[8], const float* g, const float* bt, int lane) {
    float s = 0.f;
#pragma unroll
    for (int j = 0; j < 8; ++j) s += (v[j].x + v[j].y) + (v[j].z + v[j].w);
    const float mean = wave_sum(s) * (1.f / D); float s2 = 0.f;
#pragma unroll
    for (int j = 0; j < 8; ++j) { v[j] = v[j] - mean; s2 += (v[j].x * v[j].x + v[j].y * v[j].y) + (v[j].z * v[j].z + v[j].w * v[j].w); }
    const float rstd = 1.f / sqrtf(wave_sum(s2) * (1.f / D) + LN_EPS);
#pragma unroll
    for (int j = 0; j < 8; ++j) { const f32x4 gv = *(const f32x4*)(g + j * 256 + lane * 4), bv = *(const f32x4*)(bt + j * 256 + lane * 4); v[j] = v[j] * rstd * gv + bv; }
}
template <int L, bool ROUTER, bool WRITE_HB> __device__ __forceinline__ void p_ln_mix(const Args& a, LAS unsigned char* lds, XT* X) {
    const int lane_ = threadIdx.x & 63, wave = __builtin_amdgcn_readfirstlane(threadIdx.x >> 6), tid = threadIdx.x;
    const float* g = a.in[I_LMG] + (size_t)L * D; const float* bt = a.in[I_LMB] + (size_t)L * D;
    const float* mod = (const float*)(a.ws + WS_MOD) + (size_t)L * 4 * D6;
    int* route_e = (int*)(a.ws + WS_ROUTE); float* route_w = (float*)(a.ws + WS_ROUTE + 128 * 1024); int* hist = (int*)(a.ws + WS_ROUTE + 384 * 1024);
    LAS int* el = (LAS int*)lds;
    const float* wr = a.in[I_MR];
    for (int chunk = blockIdx.x; chunk < 256; chunk += gridDim.x) {
        f32x4 v[8]; XRaw vn[8];
#pragma unroll
        for (int j = 0; j < 8; ++j) v[j] = xr2f(ldxr(X + (size_t)(chunk * 64 + wave * 8) * D + j * 256 + lane_ * 4));
#pragma unroll 1
        for (int r = 0; r < 8; ++r) {
            int lane = lane_; asm volatile("" : "+v"(lane));
            const int m = chunk * 64 + wave * 8 + r; XT* xr = X + (size_t)m * D;
            if (r < 7) {
#pragma unroll
                for (int j = 0; j < 8; ++j) vn[j] = ldxr(xr + D + j * 256 + lane * 4); }
            ln_regs(v, g, bt, lane);
#pragma unroll
            for (int j = 0; j < 8; ++j) stx4(xr + j * 256 + lane * 4, v[j]);
            if (WRITE_HB) { const float* md = mod + (size_t)(m >> 12) * D6; bf16* hb = (bf16*)(a.ws + WS_HB) + (size_t)m * D;
                f32x4 shv[8], scv[8];
#pragma unroll
                for (int j = 0; j < 8; ++j) { const int k = j * 256 + lane * 4; shv[j] = *(const f32x4*)(md + 6144 + k); scv[j] = *(const f32x4*)(md + 8192 + k); }
                __builtin_amdgcn_sched_barrier(0);
#pragma unroll
                for (int j = 0; j < 8; ++j) { const int k = j * 256 + lane * 4; const f32x4 hv = v[j] * (1.f + scv[j]) + shv[j];
                    if (FFN8_GU) *(unsigned*)((unsigned char*)(a.ws + WS_HB) + (size_t)m * D + k) = pk4_fp8(hv.x, hv.y, hv.z, hv.w); else st_bf4(hb + k, hv); }
                __builtin_amdgcn_sched_barrier(0); }
            if (ROUTER) {
                const float* md = mod + (size_t)(m >> 12) * D6;
                float lg[8] = {0.f, 0.f, 0.f, 0.f, 0.f, 0.f, 0.f, 0.f};
#pragma unroll
                for (int j = 0; j < 8; ++j) { const int k = j * 256 + lane * 4; const f32x4 sh = *(const f32x4*)(md + 6144 + k), scf = *(const f32x4*)(md + 8192 + k); const f32x4 hv = v[j] * (1.f + scf) + sh;
#pragma unroll
                    for (int i = 0; i < 4; ++i) { const f32x4 w0 = *(const f32x4*)(wr + (size_t)(k + i) * 8), w1 = *(const f32x4*)(wr + (size_t)(k + i) * 8 + 4); const float hx = hv[i];
                        lg[0] += hx * w0.x; lg[1] += hx * w0.y; lg[2] += hx * w0.z; lg[3] += hx * w0.w; lg[4] += hx * w1.x; lg[5] += hx * w1.y; lg[6] += hx * w1.z; lg[7] += hx * w1.w; } }
#pragma unroll
                for (int e = 0; e < 8; ++e) lg[e] = wave_sum(lg[e]);
                int i0 = 0; float v0 = lg[0];
#pragma unroll
                for (int e = 1; e < 8; ++e) if (lg[e] > v0) { v0 = lg[e]; i0 = e; }
                int i1 = -1; float v1 = -INFINITY;
#pragma unroll
                for (int e = 0; e < 8; ++e) if (e != i0 && lg[e] > v1) { v1 = lg[e]; i1 = e; }
                const float ex = __expf(v1 - v0), w0 = 1.f / (1.f + ex), w1 = ex / (1.f + ex);
                if (lane == 0) { route_e[m * 2] = i0; route_e[m * 2 + 1] = i1; route_w[m * 2] = w0; route_w[m * 2 + 1] = w1; el[(wave * 8 + r) * 2] = i0; el[(wave * 8 + r) * 2 + 1] = i1; }
            }
#pragma unroll
            for (int j = 0; j < 8; ++j) v[j] = xr2f(vn[j]);
        }
        if (ROUTER) {
            __syncthreads();
            if (tid < 8) { int cnt = 0; for (int i = 0; i < 128; ++i) cnt += (el[i] == tid) ? 1 : 0; hist[chunk * 8 + tid] = cnt; }
            __syncthreads();
        }
    }
}
template <int L> __device__ __forceinline__ void p_moe_slots(const Args& a, LAS unsigned char* lds, const XT* X) {
    const int lane = threadIdx.x & 63, wave = __builtin_amdgcn_readfirstlane(threadIdx.x >> 6), tid = threadIdx.x;
    const float* mod = (const float*)(a.ws + WS_MOD) + (size_t)L * 4 * D6;
    const int* route_e = (const int*)(a.ws + WS_ROUTE); int* tok_slot = (int*)(a.ws + WS_ROUTE + 256 * 1024); const int* hist = (const int*)(a.ws + WS_ROUTE + 384 * 1024);
    int* moe_base = (int*)(a.ws + WS_ROUTE + 512 * 1024); int* moe_cnt = moe_base + 16;
    bf16* hperm = (bf16*)(a.ws + WS_HPERM);
    LAS int* hl = (LAS int*)lds; LAS int* totl = hl + 2048; LAS int* befl = totl + 8; LAS int* basel = befl + 8; LAS int* el = basel + 16; LAS int* sl = el + 128;
    for (int chunk = blockIdx.x; chunk < 256; chunk += gridDim.x) {
        __syncthreads();
        for (int i = tid; i < 2048; i += 512) hl[i] = hist[i];
        if (tid < 128) el[tid] = route_e[chunk * 128 + tid];
        __syncthreads();
        { int sv = 0, bv = 0;
#pragma unroll
          for (int k = 0; k < 4; ++k) { const int c = 4 * lane + k; const int v = hl[c * 8 + wave]; sv += v; bv += (c < chunk) ? v : 0; }
#pragma unroll
          for (int o = 1; o < 64; o <<= 1) { sv += __shfl_xor(sv, o); bv += __shfl_xor(bv, o); }
          if (lane == 0) { totl[wave] = sv; befl[wave] = bv; } }
        __syncthreads();
        if (tid == 0) { int base = 0; for (int e = 0; e < 8; ++e) { basel[e] = base; base += (totl[e] + 255) & ~255; } basel[8] = base;
            if (chunk == 0) { for (int e = 0; e < 9; ++e) moe_base[e] = basel[e]; for (int e = 0; e < 8; ++e) moe_cnt[e] = totl[e]; } }
        __syncthreads();
        if (tid < 128) { const int e = el[tid]; int cnt = 0; for (int j = 0; j < tid; ++j) cnt += (el[j] == e) ? 1 : 0;
            const int slot = basel[e] + befl[e] + cnt; sl[tid] = slot; tok_slot[chunk * 128 + tid] = slot; }
        __syncthreads();
        f32x4 v[8], shv[8], scv[8]; XRaw vn[8];
        { const XT* xr = X + (size_t)(chunk * 64 + wave * 8) * D;
#pragma unroll
          for (int j = 0; j < 8; ++j) v[j] = xr2f(ldxr(xr + j * 256 + lane * 4)); }
#pragma unroll 1
        for (int tt = 0; tt < 8; ++tt) {
            const int tk = wave * 8 + tt, m = chunk * 64 + tk; const float* md = mod + (size_t)(m >> 12) * D6; const int s0 = sl[2 * tk], s1 = sl[2 * tk + 1];
            if (tt < 7) { const XT* xn = X + (size_t)(m + 1) * D;
#pragma unroll
                for (int j = 0; j < 8; ++j) vn[j] = ldxr(xn + j * 256 + lane * 4); }
#pragma unroll
            for (int j = 0; j < 8; ++j) { const int k = j * 256 + lane * 4; shv[j] = *(const f32x4*)(md + 6144 + k); scv[j] = *(const f32x4*)(md + 8192 + k); }
            __builtin_amdgcn_sched_barrier(0);
#pragma unroll
            for (int j = 0; j < 8; ++j) { const int k = j * 256 + lane * 4; const f32x4 hv = v[j] * (1.f + scv[j]) + shv[j];
                if (MOE_FP8 && FAST_GEMM) { const unsigned pk = pk4_fp8(hv.x, hv.y, hv.z, hv.w); *(unsigned*)((unsigned char*)hperm + (size_t)s0 * D + k) = pk; *(unsigned*)((unsigned char*)hperm + (size_t)s1 * D + k) = pk; }
                else { st_bf4(hperm + (size_t)s0 * D + k, hv); st_bf4(hperm + (size_t)s1 * D + k, hv); } }
#pragma unroll
            for (int j = 0; j < 8; ++j) v[j] = xr2f(vn[j]);
        }
    }
}
__device__ __forceinline__ void p_moe_gateup_g(const Args& a, LAS unsigned char* lds) {
    const int* moe_base = (const int*)(a.ws + WS_ROUTE + 512 * 1024); const int* moe_cnt = moe_base + 16;
    const bf16* hperm = (const bf16*)(a.ws + WS_HPERM); bf16* hid = (bf16*)(a.ws + WS_HID);
    const int R = moe_base[8], ntm = R / 128;
    for (int t = blockIdx.x; t < ntm * 56; t += gridDim.x) {
        const int tm = t / 56, tn = t % 56, row0 = tm * 128;
        int e = 0;
#pragma unroll
        for (int j = 1; j < 8; ++j) if (row0 >= moe_base[j]) e = j;
        if (row0 >= moe_base[e] + moe_cnt[e]) continue;
        const float* Wg = a.in[I_MWG] + (size_t)e * D * DFE; const float* Wu = a.in[I_MWU] + (size_t)e * D * DFE;
        auto al = [&](int r, int k) -> f32x4 { return ld_bf4(hperm + (size_t)r * D + k); };
        auto bl = [&](int k, int n, int which) -> f32x4 { return *(const f32x4*)((which ? Wu : Wg) + (size_t)k * DFE + n); };
        auto ep = [&](int r, int n, f32x4 gq, f32x4 uq) { f32x4 o; o.x = siluf_(gq.x) * uq.x; o.y = siluf_(gq.y) * uq.y; o.z = siluf_(gq.z) * uq.z; o.w = siluf_(gq.w) * uq.w; st_bf4(hid + (size_t)r * DFE + n, o); };
        ggemm_tile<true>((LAS float*)lds, row0, tn * 128, D, al, bl, ep);
    }
}
__device__ __forceinline__ void p_moe_down_g(const Args& a, LAS unsigned char* lds) {
    const int* moe_base = (const int*)(a.ws + WS_ROUTE + 512 * 1024); const int* moe_cnt = moe_base + 16;
    const bf16* hid = (const bf16*)(a.ws + WS_HID); float* Y = (float*)(a.ws + WS_Y);
    const int R = moe_base[8], ntm = R / 128;
    for (int t = blockIdx.x; t < ntm * 16; t += gridDim.x) {
        const int tm = t >> 4, tn = t & 15, row0 = tm * 128;
        int e = 0;
#pragma unroll
        for (int j = 1; j < 8; ++j) if (row0 >= moe_base[j]) e = j;
        if (row0 >= moe_base[e] + moe_cnt[e]) continue;
        const float* Wd = a.in[I_MWD] + (size_t)e * DFE * D;
        auto al = [&](int r, int k) -> f32x4 { return ld_bf4(hid + (size_t)r * DFE + k); };
        auto bl = [&](int k, int n, int) -> f32x4 { return *(const f32x4*)(Wd + (size_t)k * D + n); };
        auto ep = [&](int r, int n, f32x4 v, f32x4) { *(f32x4*)(Y + (size_t)r * D + n) = v; };
        ggemm_tile<false>((LAS float*)lds, row0, tn * 128, DFE, al, bl, ep);
    }
}
template <int L> __device__ __forceinline__ void p_moe_combine_ln(const Args& a, const XT* X, float* out) {
    const int lane_ = threadIdx.x & 63, wave = __builtin_amdgcn_readfirstlane(threadIdx.x >> 6);
    const float* mod = (const float*)(a.ws + WS_MOD) + (size_t)L * 4 * D6;
    const float* g = a.in[I_LFG] + (size_t)L * D; const float* bt = a.in[I_LFB] + (size_t)L * D;
    const float* route_w = (const float*)(a.ws + WS_ROUTE + 128 * 1024); const int* tok_slot = (const int*)(a.ws + WS_ROUTE + 256 * 1024); const float* Y = (const float*)(a.ws + WS_Y);
    const int gw = blockIdx.x * 8 + wave, NGW = gridDim.x * 8;
    constexpr bool YB = (MOE_FP8 && FAST_GEMM);
    int sa0 = 0, sa1 = 0, sb0 = 0, sb1 = 0; float wa0 = 0.f, wa1 = 0.f, wb0 = 0.f, wb1 = 0.f;
    if (gw < M) { sa0 = tok_slot[gw * 2]; sa1 = tok_slot[gw * 2 + 1]; wa0 = route_w[gw * 2]; wa1 = route_w[gw * 2 + 1]; }
    if (gw + NGW < M) { const int m1 = gw + NGW; sb0 = tok_slot[m1 * 2]; sb1 = tok_slot[m1 * 2 + 1]; wb0 = route_w[m1 * 2]; wb1 = route_w[m1 * 2 + 1]; }
    XRaw xv[8], xn[8]; u32x2 y0v[8], y1v[8], y0n[8], y1n[8];
    if (gw < M && YB) {
#pragma unroll
        for (int j = 0; j < 8; ++j) { const int k = j * 256 + lane_ * 4; xv[j] = ldxr(X + (size_t)gw * D + k); y0v[j] = *(const u32x2*)((const bf16*)Y + (size_t)sa0 * D + k); y1v[j] = *(const u32x2*)((const bf16*)Y + (size_t)sa1 * D + k); } }
#pragma unroll 1
    for (int m = gw; m < M; m += NGW) {
        int lane = lane_; asm volatile("" : "+v"(lane));
        const float* md = mod + (size_t)(m >> 12) * D6; const float w0 = wa0, w1 = wa1;
        f32x4 v[8];
        if (YB) {
            const int m1 = m + NGW, m2 = m + 2 * NGW;
            int sc0 = 0, sc1 = 0; float wc0 = 0.f, wc1 = 0.f;
            if (m2 < M) { sc0 = tok_slot[m2 * 2]; sc1 = tok_slot[m2 * 2 + 1]; wc0 = route_w[m2 * 2]; wc1 = route_w[m2 * 2 + 1]; }
            if (m1 < M) {
#pragma unroll
                for (int j = 0; j < 8; ++j) { const int k = j * 256 + lane * 4; xn[j] = ldxr(X + (size_t)m1 * D + k); y0n[j] = *(const u32x2*)((const bf16*)Y + (size_t)sb0 * D + k); y1n[j] = *(const u32x2*)((const bf16*)Y + (size_t)sb1 * D + k); } }
#pragma unroll
            for (int j = 0; j < 8; ++j) { const int k = j * 256 + lane * 4; const f32x4 gf = *(const f32x4*)(md + 10240 + k);
                const f32x4 ya = (f32x4){bflo(y0v[j].x), bfhi(y0v[j].x), bflo(y0v[j].y), bfhi(y0v[j].y)}, yb = (f32x4){bflo(y1v[j].x), bfhi(y1v[j].x), bflo(y1v[j].y), bfhi(y1v[j].y)};
                v[j] = ALPHA * xr2f(xv[j]) + (1.f + gf) * (w0 * ya + w1 * yb); }
#pragma unroll
            for (int j = 0; j < 8; ++j) { xv[j] = xn[j]; y0v[j] = y0n[j]; y1v[j] = y1n[j]; }
            sa0 = sb0; sa1 = sb1; wa0 = wb0; wa1 = wb1; sb0 = sc0; sb1 = sc1; wb0 = wc0; wb1 = wc1;
        } else {
            const float ww0 = route_w[m * 2], ww1 = route_w[m * 2 + 1];
            const float* y0 = Y + (size_t)tok_slot[m * 2] * D; const float* y1 = Y + (size_t)tok_slot[m * 2 + 1] * D; const XT* xr = X + (size_t)m * D;
#pragma unroll
            for (int j = 0; j < 8; ++j) { const int k = j * 256 + lane * 4; const f32x4 gf = *(const f32x4*)(md + 10240 + k); v[j] = ALPHA * xr2f(ldxr(xr + k)) + (1.f + gf) * (ww0 * *(const f32x4*)(y0 + k) + ww1 * *(const f32x4*)(y1 + k)); }
        }
        ln_regs(v, g, bt, lane);
#pragma unroll
        for (int j = 0; j < 8; ++j) *(f32x4*)(out + (size_t)m * D + j * 256 + lane * 4) = v[j];
    }
}
template <int L> __device__ __forceinline__ void p_ffn_gateup_g(const Args& a, LAS unsigned char* lds, const float* X) {
    const float* mod = (const float*)(a.ws + WS_MOD) + (size_t)L * 4 * D6;
    const float* Wg = a.in[I_FWG]; const float* Wu = a.in[I_FWU]; bf16* hid = (bf16*)(a.ws + WS_HID);
    auto al = [&](int m, int k) -> f32x4 { const float* md = mod + (size_t)(m >> 12) * D6; const f32x4 x = *(const f32x4*)(X + (size_t)m * D + k); const f32x4 sh = *(const f32x4*)(md + 6144 + k), scf = *(const f32x4*)(md + 8192 + k); return x * (1.f + scf) + sh; };
    auto bl = [&](int k, int n, int which) -> f32x4 { return *(const f32x4*)((which ? Wu : Wg) + (size_t)k * DFF + n); };
    auto ep = [&](int r, int n, f32x4 gq, f32x4 uq) { f32x4 o; o.x = siluf_(gq.x) * uq.x; o.y = siluf_(gq.y) * uq.y; o.z = siluf_(gq.z) * uq.z; o.w = siluf_(gq.w) * uq.w; st_bf4(hid + (size_t)r * DFF + n, o); };
    for (int t = blockIdx.x; t < (M / 128) * (DFF / 128); t += gridDim.x) { const int tm = t / (DFF / 128), tn = t % (DFF / 128); ggemm_tile<true>((LAS float*)lds, tm * 128, tn * 128, D, al, bl, ep); }
}
template <int L> __device__ __forceinline__ void p_ffn_down_g(const Args& a, LAS unsigned char* lds, const float* X, float* xout) {
    const float* mod = (const float*)(a.ws + WS_MOD) + (size_t)L * 4 * D6;
    const float* Wd = a.in[I_FWD]; const bf16* hid = (const bf16*)(a.ws + WS_HID);
    auto al = [&](int m, int k) -> f32x4 { return ld_bf4(hid + (size_t)m * DFF + k); };
    auto bl = [&](int k, int n, int) -> f32x4 { return *(const f32x4*)(Wd + (size_t)k * D + n); };
    auto ep = [&](int m, int n, f32x4 v, f32x4) { const f32x4 gf = *(const f32x4*)(mod + (size_t)(m >> 12) * D6 + 10240 + n); const f32x4 x = *(const f32x4*)(X + (size_t)m * D + n);
        *(f32x4*)(xout + (size_t)m * D + n) = ALPHA * x + (1.f + gf) * v; };
    for (int t = blockIdx.x; t < (M / 128) * (D / 128); t += gridDim.x) { const int tm = t >> 4, tn = t & 15; ggemm_tile<false>((LAS float*)lds, tm * 128, tn * 128, DFF, al, bl, ep); }
}
template <int L, bool NEXT_HB> __device__ __forceinline__ void p_ln_ffn(const Args& a, XT* X) {
    const float* modn = (const float*)(a.ws + WS_MOD) + (size_t)(L + 1) * 4 * D6;
    const int lane_ = threadIdx.x & 63, wave = __builtin_amdgcn_readfirstlane(threadIdx.x >> 6);
    const float* g = a.in[I_LFG] + (size_t)L * D; const float* bt = a.in[I_LFB] + (size_t)L * D;
    const int gw = blockIdx.x * 8 + wave, NGW = gridDim.x * 8;
    f32x4 v[8]; XRaw vn[8];
    if (gw < M) {
#pragma unroll
        for (int j = 0; j < 8; ++j) v[j] = xr2f(ldxr(X + (size_t)gw * D + j * 256 + lane_ * 4)); }
#pragma unroll 1
    for (int m = gw; m < M; m += NGW) { int lane = lane_; asm volatile("" : "+v"(lane)); XT* xr = X + (size_t)m * D; const int mn = m + NGW;
        if (mn < M) {
#pragma unroll
            for (int j = 0; j < 8; ++j) vn[j] = ldxr(X + (size_t)mn * D + j * 256 + lane * 4); }
        ln_regs(v, g, bt, lane);
#pragma unroll
        for (int j = 0; j < 8; ++j) stx4(xr + j * 256 + lane * 4, v[j]);
        if (NEXT_HB) { const float* md = modn + (size_t)(m >> 12) * D6; bf16* hb = (bf16*)(a.ws + WS_HB) + (size_t)m * D; f32x4 shv[8], scv[8];
#pragma unroll
            for (int j = 0; j < 8; ++j) { const int k = j * 256 + lane * 4; shv[j] = *(const f32x4*)(md + k); scv[j] = *(const f32x4*)(md + 2048 + k); }
            __builtin_amdgcn_sched_barrier(0);
#pragma unroll
            for (int j = 0; j < 8; ++j) st_bf4(hb + j * 256 + lane * 4, v[j] * (1.f + scv[j]) + shv[j]);
            __builtin_amdgcn_sched_barrier(0); }
#pragma unroll
        for (int j = 0; j < 8; ++j) v[j] = xr2f(vn[j]); }
}


typedef short bf16x8 __attribute__((ext_vector_type(8)));
typedef float f32x16 __attribute__((ext_vector_type(16)));
typedef short s16x4 __attribute__((ext_vector_type(4)));
constexpr int NK_ROW = 272, NV_ROW = 136, NBUF = 17408;
constexpr float SM_C = 0.08838834764831845f * 1.4426950408889634f;

typedef const GAS unsigned char* gcp;
template <class TT> __device__ __forceinline__ TT gld(gcp p) { return *(const GAS TT*)p; }
__device__ __forceinline__ gcp uniform_ptr(const void* p) { const unsigned long long v = (unsigned long long)p; const unsigned lo = __builtin_amdgcn_readfirstlane((unsigned)v), hi = __builtin_amdgcn_readfirstlane((unsigned)(v >> 32)); return (gcp)(((unsigned long long)hi << 32) | lo); }
__device__ __forceinline__ void nsa_ld2(const bf16* base, unsigned off, u32x4& k0, u32x4& k1) { const gcp p = uniform_ptr(base) + off; k0 = gld<u32x4>(p); k1 = gld<u32x4>(p + 16); }
__device__ __forceinline__ void nsa_st_k(LAS unsigned char* buf, int tid, u32x4 k0, u32x4 k1) { LAS unsigned char* q = buf + (tid >> 3) * NK_ROW + (tid & 7) * 32; *(LAS u32x4*)q = k0; *(LAS u32x4*)(q + 16) = k1; }

__device__ __forceinline__ void nsa_st_v(LAS unsigned char* buf, int tid, u32x4 v0, u32x4 v1) { LAS u32x2* q = (LAS u32x2*)(buf + (tid >> 2) * NV_ROW + (tid & 3) * 32); q[0] = (u32x2){v0.x, v0.y}; q[1] = (u32x2){v0.z, v0.w}; q[2] = (u32x2){v1.x, v1.y}; q[3] = (u32x2){v1.z, v1.w}; }
#ifndef NSA_QKB
#define NSA_QKB 2
#endif
__device__ __forceinline__ void nsa_qk(const LAS unsigned char* kbuf, const bf16x8 (&qf)[8], int r, int h, f32x16& p0, f32x16& p1) {
    const LAS unsigned char* kp = kbuf + r * NK_ROW + h * 16;
#pragma unroll
    for (int i = 0; i < 16; ++i) { p0[i] = 0.f; p1[i] = 0.f; }
    bf16x8 a0[NSA_QKB], a1[NSA_QKB], b0[NSA_QKB], b1[NSA_QKB];
#pragma unroll
    for (int k4 = 0; k4 < NSA_QKB; ++k4) { a0[k4] = *(const LAS bf16x8*)(kp + k4 * 32); a1[k4] = *(const LAS bf16x8*)(kp + 32 * NK_ROW + k4 * 32); }
    __builtin_amdgcn_sched_barrier(0);
#pragma unroll
    for (int kb = 0; kb < 8 / NSA_QKB; kb += 2) {
        if (kb + 1 < 8 / NSA_QKB) {
#pragma unroll
            for (int k4 = 0; k4 < NSA_QKB; ++k4) { b0[k4] = *(const LAS bf16x8*)(kp + (NSA_QKB * (kb + 1) + k4) * 32); b1[k4] = *(const LAS bf16x8*)(kp + 32 * NK_ROW + (NSA_QKB * (kb + 1) + k4) * 32); } }
        __builtin_amdgcn_sched_barrier(0);
#pragma unroll
        for (int k4 = 0; k4 < NSA_QKB; ++k4) { p0 = __builtin_amdgcn_mfma_f32_32x32x16_bf16(a0[k4], qf[NSA_QKB * kb + k4], p0, 0, 0, 0); p1 = __builtin_amdgcn_mfma_f32_32x32x16_bf16(a1[k4], qf[NSA_QKB * kb + k4], p1, 0, 0, 0); }
        __builtin_amdgcn_sched_barrier(0);
        if (kb + 2 < 8 / NSA_QKB) {
#pragma unroll
            for (int k4 = 0; k4 < NSA_QKB; ++k4) { a0[k4] = *(const LAS bf16x8*)(kp + (NSA_QKB * (kb + 2) + k4) * 32); a1[k4] = *(const LAS bf16x8*)(kp + 32 * NK_ROW + (NSA_QKB * (kb + 2) + k4) * 32); } }
        __builtin_amdgcn_sched_barrier(0);
        if (kb + 1 < 8 / NSA_QKB) {
#pragma unroll
            for (int k4 = 0; k4 < NSA_QKB; ++k4) { p0 = __builtin_amdgcn_mfma_f32_32x32x16_bf16(b0[k4], qf[NSA_QKB * (kb + 1) + k4], p0, 0, 0, 0); p1 = __builtin_amdgcn_mfma_f32_32x32x16_bf16(b1[k4], qf[NSA_QKB * (kb + 1) + k4], p1, 0, 0, 0); } }
        __builtin_amdgcn_sched_barrier(0);
    }
}
__device__ __forceinline__ bf16x8 nsa_pack8(const f32x16& p, int s) { u32x4 w; w.x = pg8::cvt_pk_bf16(p[8 * s + 0], p[8 * s + 1]); w.y = pg8::cvt_pk_bf16(p[8 * s + 2], p[8 * s + 3]); w.z = pg8::cvt_pk_bf16(p[8 * s + 4], p[8 * s + 5]); w.w = pg8::cvt_pk_bf16(p[8 * s + 6], p[8 * s + 7]); return __builtin_bit_cast(bf16x8, w); }
__device__ __forceinline__ void nsa_pv_rd(const LAS unsigned char* vbuf, int dt, int r, int h, bf16x8 (&af)[2][2]) {
#pragma unroll
    for (int kh = 0; kh < 2; ++kh)
#pragma unroll
        for (int ss = 0; ss < 2; ++ss) { const LAS unsigned char* vp = vbuf + (32 * dt + r) * NV_ROW + (32 * kh + 16 * ss) * 2 + 16 * h;
            const s16x4 lo = *(const LAS s16x4*)vp, hi = *(const LAS s16x4*)(vp + 8);
            af[kh][ss] = (bf16x8){lo[0], lo[1], lo[2], lo[3], hi[0], hi[1], hi[2], hi[3]}; }
}
__device__ __forceinline__ void nsa_pv_mm(const bf16x8 (&af)[2][2], const bf16x8 (&pf)[2][2], f32x16& o) {
#pragma unroll
    for (int kh = 0; kh < 2; ++kh)
#pragma unroll
        for (int ss = 0; ss < 2; ++ss) o = __builtin_amdgcn_mfma_f32_32x32x16_bf16(af[kh][ss], pf[kh][ss], o, 0, 0, 0);
}
#ifndef NSA_PV_PP
#define NSA_PV_PP 1
#endif
__device__ __forceinline__ void nsa_pv(const LAS unsigned char* vbuf, const bf16x8 (&pf)[2][2], f32x16 (&o)[4], int r, int h) {
#if !NSA_PV_PP
#pragma unroll
    for (int dt = 0; dt < 4; ++dt) { bf16x8 fa[2][2]; nsa_pv_rd(vbuf, dt, r, h, fa); __builtin_amdgcn_sched_barrier(0); nsa_pv_mm(fa, pf, o[dt]); __builtin_amdgcn_sched_barrier(0); }
    return;
#endif
    bf16x8 fa[2][2], fb[2][2];
    nsa_pv_rd(vbuf, 0, r, h, fa);
    __builtin_amdgcn_sched_barrier(0);
    nsa_pv_rd(vbuf, 1, r, h, fb);
    __builtin_amdgcn_sched_barrier(0);
    nsa_pv_mm(fa, pf, o[0]);
    __builtin_amdgcn_sched_barrier(0);
    nsa_pv_rd(vbuf, 2, r, h, fa);
    __builtin_amdgcn_sched_barrier(0);
    nsa_pv_mm(fb, pf, o[1]);
    __builtin_amdgcn_sched_barrier(0);
    nsa_pv_rd(vbuf, 3, r, h, fb);
    __builtin_amdgcn_sched_barrier(0);
    nsa_pv_mm(fa, pf, o[2]);
    __builtin_amdgcn_sched_barrier(0);
    nsa_pv_mm(fb, pf, o[3]);
    __builtin_amdgcn_sched_barrier(0);
}
__device__ __forceinline__ float nsa_rowmax(const f32x16& p0, const f32x16& p1) { float mx = fmaxf(p0[0], p1[0]);
#pragma unroll
    for (int i = 1; i < 16; ++i) mx = fmaxf(mx, fmaxf(p0[i], p1[i]));
    return mx; }


#ifndef NSA_DMA
#define NSA_DMA 1
#endif
constexpr int NRING = 3, NTB = 16384;
__device__ __forceinline__ void glds16(const void* gsrc, unsigned lds_dst) { unsigned keep;
    asm volatile("s_mov_b32 %0, m0\n\ts_mov_b32 m0, %2\n\ts_nop 0\n\tglobal_load_lds_dwordx4 %1, off\n\ts_mov_b32 m0, %0" : "=&s"(keep) : "v"(gsrc), "s"(lds_dst) : "memory"); }
__device__ __forceinline__ void nsa_dma_tile(const bf16* kt, unsigned kstr, const bf16* vt, unsigned vstr, unsigned ldsK, unsigned ldsV, int w, int lane) {
#pragma unroll
    for (int i = 0; i < 2; ++i) { const int q = 2 * w + i, row = 4 * q + (lane >> 4), c = (lane & 15) ^ (row & 15);
        glds16((const unsigned char*)kt + ((size_t)row * kstr + c * 16), (unsigned)__builtin_amdgcn_readfirstlane((int)(ldsK + q * 1024))); }
#pragma unroll
    for (int i = 0; i < 2; ++i) { const int q = 2 * w + i, row = 8 * q + (lane >> 3), c = (lane & 7) ^ ((row >> 1) & 7);
        glds16((const unsigned char*)vt + ((size_t)row * vstr + c * 16), (unsigned)__builtin_amdgcn_readfirstlane((int)(ldsV + q * 1024))); }
}
__device__ __forceinline__ void nsa_qk_sw(const LAS unsigned char* kbuf, const bf16x8 (&qf)[8], int r, int h, f32x16& p0, f32x16& p1) {
    const int x = r & 15; const LAS unsigned char* kA = kbuf + r * 256 + ((h ^ (x & 1)) * 16); const int xk = (x & 14) * 16;
#pragma unroll
    for (int i = 0; i < 16; ++i) { p0[i] = 0.f; p1[i] = 0.f; }
    bf16x8 a0, a1, b0, b1;
    a0 = *(const LAS bf16x8*)(kA + (0 ^ xk)); a1 = *(const LAS bf16x8*)(kA + (0 ^ xk) + 8192); __builtin_amdgcn_sched_barrier(0);
#pragma unroll
    for (int ks = 0; ks < 8; ks += 2) {
        b0 = *(const LAS bf16x8*)(kA + (((ks + 1) * 32) ^ xk)); b1 = *(const LAS bf16x8*)(kA + (((ks + 1) * 32) ^ xk) + 8192); __builtin_amdgcn_sched_barrier(0);
        p0 = __builtin_amdgcn_mfma_f32_32x32x16_bf16(a0, qf[ks], p0, 0, 0, 0); p1 = __builtin_amdgcn_mfma_f32_32x32x16_bf16(a1, qf[ks], p1, 0, 0, 0); __builtin_amdgcn_sched_barrier(0);
        if (ks + 2 < 8) { a0 = *(const LAS bf16x8*)(kA + (((ks + 2) * 32) ^ xk)); a1 = *(const LAS bf16x8*)(kA + (((ks + 2) * 32) ^ xk) + 8192); } __builtin_amdgcn_sched_barrier(0);
        p0 = __builtin_amdgcn_mfma_f32_32x32x16_bf16(b0, qf[ks + 1], p0, 0, 0, 0); p1 = __builtin_amdgcn_mfma_f32_32x32x16_bf16(b1, qf[ks + 1], p1, 0, 0, 0); __builtin_amdgcn_sched_barrier(0);
    }
}
__device__ __forceinline__ void nsa_pv_rd4(const LAS unsigned char* vA, int sv, int step, bf16x8 (&af)[4]) {
#pragma unroll
    for (int dt = 0; dt < 4; ++dt) af[dt] = *(const LAS bf16x8*)(vA + dt * 4096 + (((2 * step) * 16) ^ sv));
}
__device__ __forceinline__ void nsa_pv_mm4(const bf16x8 (&af)[4], const bf16x8& pfk, f32x16 (&o)[4]) {
#pragma unroll
    for (int dt = 0; dt < 4; ++dt) o[dt] = __builtin_amdgcn_mfma_f32_32x32x16_bf16(af[dt], pfk, o[dt], 0, 0, 0);
}
__device__ __forceinline__ void nsa_pv_sw(const LAS unsigned char* vbuf, const bf16x8 (&pf)[2][2], f32x16 (&o)[4], int r, int h) {
    const int sv = (((r >> 1) & 7) ^ h) * 16; const LAS unsigned char* vA = vbuf + r * 128;
#pragma unroll
    for (int step = 0; step < 4; ++step) { bf16x8 fa[4];
        nsa_pv_rd4(vA, sv, step, fa); __builtin_amdgcn_sched_barrier(0);
        nsa_pv_mm4(fa, pf[step >> 1][step & 1], o); __builtin_amdgcn_sched_barrier(0); }
}
__device__ __forceinline__ void nsa_unit(const Args& a, LAS unsigned char* lds, int b, int kvh, int qb) {
    const int tid = threadIdx.x, lane = tid & 63, w = __builtin_amdgcn_readfirstlane(tid >> 6), r = lane & 31, h = lane >> 5;
    const int ql = 8 * w + (r >> 2), g = r & 3, t = 64 * qb + ql; const size_t m = (size_t)b * T + t;
    const bf16* proj = (const bf16*)(a.ws + WS_PROJ);
    const gcp projU = uniform_ptr(proj); const unsigned prow_off = (unsigned)m * (unsigned)(PW * 2);
    const float NINF = -INFINITY;
    const unsigned offk = (unsigned)(((tid >> 3) * PW + (tid & 7) * 16) * 2), offv = (unsigned)(((tid >> 2) * VTP + (tid & 3) * 16) * 2);
    const unsigned offkc = (unsigned)(((tid >> 3) * 128 + (tid & 7) * 16) * 2), offvc = (unsigned)(((tid >> 2) * 256 + (tid & 3) * 16) * 2);
    constexpr int IMPW_OFF = NSA_DMA ? 7 * NTB : 4 * NBUF;
    LAS float* impw = (LAS float*)(lds + IMPW_OFF + w * 4096); LAS unsigned* selw = (LAS unsigned*)(lds + IMPW_OFF + 32768 + w * 64);
    bf16x8 qf[8];
    { const gcp qp = projU + (prow_off + (unsigned)((PQ + (kvh * 4 + g) * 128 + 8 * h) * 2));
#pragma unroll
      for (int ks = 0; ks < 8; ++ks) qf[ks] = gld<bf16x8>(qp + 32 * ks); }
    float g0, g1, g2; { const gcp gp = projU + (prow_off + (unsigned)((PNG + (kvh * 4 + g) * 3) * 2)); g0 = sigmoidf_(bf1(gld<bf16>(gp))); g1 = sigmoidf_(bf1(gld<bf16>(gp + 2))); g2 = sigmoidf_(bf1(gld<bf16>(gp + 4))); }
    const int tmax = 64 * qb + 63, ntc = ((((tmax - 31) >> 4) + 1) + 63) >> 6;
    const int ncv = (t >= 31) ? ((t - 31) >> 4) + 1 : 0;
    const bf16* kcb = (const bf16*)(a.ws + WS_KCB) + (size_t)((b * 2 + kvh) * 256) * 128; const bf16* vct = (const bf16*)(a.ws + WS_VCT) + (size_t)((b * 2 + kvh) * 128) * 256;
    __syncthreads();
#pragma unroll
    for (int ct = 0; ct < 4; ++ct) if (ct < ntc) { u32x4 k0, k1; nsa_ld2(kcb + (size_t)ct * 64 * 128, offkc, k0, k1); nsa_st_k(lds + ct * NBUF, tid, k0, k1); }
    __syncthreads();
    float mx = -1e30f, ls = 0.f;
#pragma unroll 1
    for (int ct = 0; ct < ntc; ++ct) { f32x16 s0, s1; nsa_qk(lds + ct * NBUF, qf, r, h, s0, s1);
#pragma unroll
        for (int i = 0; i < 16; ++i) { const int c0 = 64 * ct + (i & 3) + 8 * (i >> 2) + 4 * h; s0[i] = (c0 < ncv) ? s0[i] : NINF; s1[i] = (c0 + 32 < ncv) ? s1[i] : NINF; }
        float tmx = nsa_rowmax(s0, s1); tmx = fmaxf(tmx, __shfl_xor(tmx, 32));
        const float mnew = fmaxf(mx, tmx), alpha = __builtin_amdgcn_exp2f((mx - mnew) * SM_C), nmc = -mnew * SM_C; mx = mnew;
        float la = 0.f;
#pragma unroll
        for (int i = 0; i < 16; ++i) la += __builtin_amdgcn_exp2f(fmaf(s0[i], SM_C, nmc)) + __builtin_amdgcn_exp2f(fmaf(s1[i], SM_C, nmc));
        ls = ls * alpha + la; }
    ls += __shfl_xor(ls, 32);
    const float cinv = ls > 0.f ? 1.f / ls : 0.f, cnmc = -mx * SM_C;
    bf16x8 pfc[4][2][2];
#pragma unroll
    for (int ct = 0; ct < 4; ++ct) {
        f32x16 S2[2];
        if (ct < ntc) { nsa_qk(lds + ct * NBUF, qf, r, h, S2[0], S2[1]);
#pragma unroll
            for (int i = 0; i < 16; ++i) { const int c0 = 64 * ct + (i & 3) + 8 * (i >> 2) + 4 * h;
                S2[0][i] = (c0 < ncv) ? __builtin_amdgcn_exp2f(fmaf(S2[0][i], SM_C, cnmc)) * cinv : 0.f; S2[1][i] = (c0 + 32 < ncv) ? __builtin_amdgcn_exp2f(fmaf(S2[1][i], SM_C, cnmc)) * cinv : 0.f; }
        } else {
#pragma unroll
            for (int i = 0; i < 16; ++i) { S2[0][i] = 0.f; S2[1][i] = 0.f; } }
#pragma unroll
        for (int kh = 0; kh < 2; ++kh)
#pragma unroll
            for (int aa = 0; aa < 4; ++aa) { float G = (S2[kh][4 * aa] + S2[kh][4 * aa + 1]) + (S2[kh][4 * aa + 2] + S2[kh][4 * aa + 3]); float Lv = S2[kh][4 * aa + 3];
                G += __shfl_xor(G, 1); G += __shfl_xor(G, 2); Lv += __shfl_xor(Lv, 1); Lv += __shfl_xor(Lv, 2);
                const int n = 16 * ct + 8 * kh + 2 * aa + h;
                if (g == 0) { impw[(r >> 2) * 64 + n] = G; impw[512 + (r >> 2) * 64 + n] = Lv; } }
#pragma unroll
        for (int kh = 0; kh < 2; ++kh) { pfc[ct][kh][0] = nsa_pack8(S2[kh], 0); pfc[ct][kh][1] = nsa_pack8(S2[kh], 1); }
    }
    __syncthreads();
    u32x4 sv0[4], sv1[4];
#pragma unroll
    for (int ct = 0; ct < 4; ++ct) if (ct < ntc) nsa_ld2(vct + ct * 64, offvc, sv0[ct], sv1[ct]);
#pragma unroll 1
    for (int qq = 0; qq < 8; ++qq) {
        const float imp = impw[qq * 64 + lane] + (lane > 0 ? impw[512 + qq * 64 + lane - 1] : 0.f);
        const float iv = (lane > qb) ? NINF : ((lane == 0 || lane == qb || lane == qb - 1) ? 1e9f : imp);
        const unsigned ub = __builtin_bit_cast(unsigned, iv); unsigned key = (ub & 0x80000000u) ? ~ub : (ub | 0x80000000u); key = (key & ~63u) | (unsigned)(63 - lane);
        unsigned thr = 0u;
#pragma unroll
        for (int bit = 31; bit >= 0; --bit) { const unsigned cand = thr | (1u << bit); const int cnt = __builtin_popcountll(__ballot(key >= cand)); thr = (cnt >= 16) ? cand : thr; }
        const unsigned long long msk = __ballot(key >= thr);
        if (lane == 0) { selw[qq * 2] = (unsigned)msk; selw[qq * 2 + 1] = (unsigned)(msk >> 32); }
    }
    const unsigned long long selmask = (unsigned long long)selw[(r >> 2) * 2] | ((unsigned long long)selw[(r >> 2) * 2 + 1] << 32);
#pragma unroll
    for (int ct = 0; ct < 4; ++ct) if (ct < ntc) nsa_st_v(lds + ct * NBUF, tid, sv0[ct], sv1[ct]);
    __syncthreads();
    f32x16 o[4];
#pragma unroll
    for (int dt = 0; dt < 4; ++dt)
#pragma unroll
        for (int i = 0; i < 16; ++i) o[dt][i] = 0.f;
#pragma unroll
    for (int ct = 0; ct < 4; ++ct) if (ct < ntc) nsa_pv(lds + ct * NBUF, pfc[ct], o, r, h);
    GAS unsigned char* mp = (GAS unsigned char*)uniform_ptr(a.ws + WS_MIX) + ((unsigned)m * 4096u + (unsigned)(((kvh * 4 + g) * 128 + 4 * h) * 2));
#pragma unroll
    for (int dt = 0; dt < 4; ++dt)
#pragma unroll
        for (int aa = 0; aa < 4; ++aa) { u32x2 wv; wv.x = pg8::cvt_pk_bf16(o[dt][4 * aa] * g0, o[dt][4 * aa + 1] * g0); wv.y = pg8::cvt_pk_bf16(o[dt][4 * aa + 2] * g0, o[dt][4 * aa + 3] * g0); *(GAS u32x2*)(mp + (32 * dt + 8 * aa) * 2) = wv; }
    { const gcp rpb = uniform_ptr(a.ws + WS_ROPE) + (unsigned)((t * 32 + 8 * h) * 4);
      u32x4 w0 = __builtin_bit_cast(u32x4, qf[0]), w1 = __builtin_bit_cast(u32x4, qf[1]);
#pragma unroll
      for (int jj = 0; jj < 4; ++jj) { const float c0 = gld<float>(rpb + 8 * jj), c1 = gld<float>(rpb + 8 * jj + 4), s0 = gld<float>(rpb + 64 + 8 * jj), s1 = gld<float>(rpb + 64 + 8 * jj + 4);
          const float xa0 = bflo(w0[jj]), xa1 = bfhi(w0[jj]), xb0 = bflo(w1[jj]), xb1 = bfhi(w1[jj]);
          w0[jj] = pg8::cvt_pk_bf16(xa0 * c0 - xb0 * s0, xa1 * c1 - xb1 * s1); w1[jj] = pg8::cvt_pk_bf16(xb0 * c0 + xa0 * s0, xb1 * c1 + xa1 * s1); }
      qf[0] = __builtin_bit_cast(bf16x8, w0); qf[1] = __builtin_bit_cast(bf16x8, w1); }
    const int nS = qb + 1, jlo = qb > 8 ? qb - 8 : 0, nTot = nS + (qb - jlo + 1);
    const bf16* ksb = proj + (size_t)b * T * PW + PKS + kvh * 128; const bf16* kwb = proj + (size_t)b * T * PW + PKW + kvh * 128;
    const bf16* vsb = (const bf16*)(a.ws + WS_VTS) + (size_t)((b * 2 + kvh) * 128) * VTP; const bf16* vwb = (const bf16*)(a.ws + WS_VTW) + (size_t)((b * 2 + kvh) * 128) * VTP;
#if NSA_DMA
    const unsigned ldsb = (unsigned)(size_t)lds;
    constexpr int KRING = 3, VOFF = KRING * NTB;
    auto tile_src = [&](int i2, const bf16*& kt, const bf16*& vt) { if (i2 < nS) { kt = ksb + (size_t)(64 * i2) * PW; vt = vsb + 64 * i2; } else { const int j = jlo + i2 - nS; kt = kwb + (size_t)(64 * j) * PW; vt = vwb + 64 * j; } };
    __syncthreads();
    { const bf16 *kt, *vt; tile_src(0, kt, vt); nsa_dma_tile(kt, PW * 2, vt, VTP * 2, ldsb, ldsb + VOFF, w, lane);
      if (nTot > 1) { tile_src(1, kt, vt); nsa_dma_tile(kt, PW * 2, vt, VTP * 2, ldsb + NTB, ldsb + VOFF + NTB, w, lane); } }
#pragma unroll
    for (int dt = 0; dt < 4; ++dt)
#pragma unroll
        for (int i = 0; i < 16; ++i) o[dt][i] = 0.f;
    float mrun = -1e30f, lrun = 0.f;
    f32x16 p0, p1;
#pragma unroll
    for (int i = 0; i < 16; ++i) { p0[i] = 0.f; p1[i] = 0.f; }
    bf16x8 pf[2][2];
    if (w >= 4) asm volatile("s_barrier" ::: "memory");
#pragma unroll 1
    for (int it = 0; it <= nTot; ++it) {
        if (it + 1 < nTot) asm volatile("s_waitcnt vmcnt(4) lgkmcnt(0)\n\ts_barrier" ::: "memory"); else asm volatile("s_waitcnt vmcnt(0) lgkmcnt(0)\n\ts_barrier" ::: "memory");
        if (it > 0) { const int ti = it - 1;
            bool lane_on = true; bool edge = false; int klo = 0, khi = 63;
            if (ti < nS) { lane_on = ((selmask >> ti) & 1ull) != 0ull; if (ti == qb) { edge = true; khi = ql; } }
            else { const int j = jlo + ti - nS; if (j == qb) { edge = true; khi = ql; } if (j == qb - 8) { edge = true; klo = ql + 1; } }
            if (edge) {
#pragma unroll
                for (int i = 0; i < 16; ++i) { const int kl = (i & 3) + 8 * (i >> 2) + 4 * h; p0[i] = (kl >= klo && kl <= khi) ? p0[i] : NINF; p1[i] = (kl + 32 >= klo && kl + 32 <= khi) ? p1[i] : NINF; } }
            float tmx = nsa_rowmax(p0, p1); tmx = lane_on ? tmx : NINF; tmx = fmaxf(tmx, __shfl_xor(tmx, 32));
            float alpha = 1.f;
            if (__any((tmx - mrun) * SM_C > 8.f)) { const float mnew = fmaxf(mrun, tmx); alpha = __builtin_amdgcn_exp2f((mrun - mnew) * SM_C); mrun = mnew;
#pragma unroll
                for (int dt = 0; dt < 4; ++dt) o[dt] *= alpha; }
            const float nmc = lane_on ? -mrun * SM_C : NINF;
            float ls = 0.f;
#pragma unroll
            for (int i = 0; i < 16; ++i) { p0[i] = __builtin_amdgcn_exp2f(fmaf(p0[i], SM_C, nmc)); p1[i] = __builtin_amdgcn_exp2f(fmaf(p1[i], SM_C, nmc)); ls += p0[i] + p1[i]; }
            lrun = lrun * alpha + ls;
            pf[0][0] = nsa_pack8(p0, 0); pf[0][1] = nsa_pack8(p0, 1); pf[1][0] = nsa_pack8(p1, 0); pf[1][1] = nsa_pack8(p1, 1);
        }
        asm volatile("s_waitcnt lgkmcnt(0)\n\ts_barrier" ::: "memory");
        if (it + 2 < nTot) { const bf16 *kt, *vt; tile_src(it + 2, kt, vt); const int t2 = it + 2;
            int lo_ = lane; asm volatile("" : "+v"(lo_)); nsa_dma_tile(kt, PW * 2, vt, VTP * 2, ldsb + (t2 % 3) * NTB, ldsb + VOFF + (t2 & 3) * NTB, w, lo_); }
        int ro = r, ho = h; asm volatile("" : "+v"(ro), "+v"(ho));
        if (it > 0) { const int ti = it - 1;
            nsa_pv_sw(lds + VOFF + (ti & 3) * NTB, pf, o, ro, ho);
            if (ti == nS - 1 || ti == nTot - 1) {
                const float lt = lrun + __shfl_xor(lrun, 32); const float f = ((ti == nS - 1) ? g1 : g2) / lt;
#pragma unroll
                for (int dt = 0; dt < 4; ++dt) {
#pragma unroll
                    for (int aa = 0; aa < 4; ++aa) { const u32x2 pv = *(const GAS u32x2*)(mp + (32 * dt + 8 * aa) * 2); u32x2 wv;
                        wv.x = pg8::cvt_pk_bf16(bflo(pv.x) + o[dt][4 * aa] * f, bfhi(pv.x) + o[dt][4 * aa + 1] * f); wv.y = pg8::cvt_pk_bf16(bflo(pv.y) + o[dt][4 * aa + 2] * f, bfhi(pv.y) + o[dt][4 * aa + 3] * f);
                        *(GAS u32x2*)(mp + (32 * dt + 8 * aa) * 2) = wv; }
#pragma unroll
                    for (int i = 0; i < 16; ++i) o[dt][i] = 0.f; }
                mrun = -1e30f; lrun = 0.f;
                asm volatile("s_waitcnt vmcnt(0)" ::: "memory");
            }
        }
        if (it < nTot) nsa_qk_sw(lds + (it % 3) * NTB, qf, ro, ho, p0, p1);
    }
    if (w < 4) asm volatile("s_barrier" ::: "memory");
    __syncthreads();
#else
    u32x4 k0, k1, v0, v1;
    __syncthreads();
    nsa_ld2(ksb, offk, k0, k1); nsa_ld2(vsb, offv, v0, v1);
    nsa_st_k(lds, tid, k0, k1); nsa_st_v(lds + 2 * NBUF, tid, v0, v1);
    __syncthreads();
#pragma unroll
    for (int dt = 0; dt < 4; ++dt)
#pragma unroll
        for (int i = 0; i < 16; ++i) o[dt][i] = 0.f;
    float mrun = -1e30f, lrun = 0.f;
#pragma unroll 1
    for (int it = 0; it < nTot; ++it) {
        const LAS unsigned char* kbuf = lds + (it & 1) * NBUF; const LAS unsigned char* vbuf = lds + (2 + (it & 1)) * NBUF;
        const bf16* kn = ksb; const bf16* vn = vsb;
        if (it + 1 < nTot) { const int i2 = it + 1;
            if (i2 < nS) { kn = ksb + (size_t)(64 * i2) * PW; vn = vsb + 64 * i2; }
            else { const int j = jlo + i2 - nS; kn = kwb + (size_t)(64 * j) * PW; vn = vwb + 64 * j; }
            nsa_ld2(kn, offk, k0, k1); }
        f32x16 p0, p1;
        nsa_qk(kbuf, qf, r, h, p0, p1);
        if (it + 1 < nTot) { nsa_st_k(lds + ((it + 1) & 1) * NBUF, tid, k0, k1); nsa_ld2(vn, offv, v0, v1); }
        bool lane_on = true; bool edge = false; int klo = 0, khi = 63;
        if (it < nS) { lane_on = ((selmask >> it) & 1ull) != 0ull; if (it == qb) { edge = true; khi = ql; } }
        else { const int j = jlo + it - nS; if (j == qb) { edge = true; khi = ql; } if (j == qb - 8) { edge = true; klo = ql + 1; } }
        if (edge) {
#pragma unroll
            for (int i = 0; i < 16; ++i) { const int kl = (i & 3) + 8 * (i >> 2) + 4 * h; p0[i] = (kl >= klo && kl <= khi) ? p0[i] : NINF; p1[i] = (kl + 32 >= klo && kl + 32 <= khi) ? p1[i] : NINF; } }
        float tmx = nsa_rowmax(p0, p1); tmx = lane_on ? tmx : NINF; tmx = fmaxf(tmx, __shfl_xor(tmx, 32));
        const float mnew = fmaxf(mrun, tmx), alpha = __builtin_amdgcn_exp2f((mrun - mnew) * SM_C), nmc = lane_on ? -mnew * SM_C : NINF; mrun = mnew;
        float ls = 0.f;
#pragma unroll
        for (int i = 0; i < 16; ++i) { p0[i] = __builtin_amdgcn_exp2f(fmaf(p0[i], SM_C, nmc)); p1[i] = __builtin_amdgcn_exp2f(fmaf(p1[i], SM_C, nmc)); ls += p0[i] + p1[i]; }
        lrun = lrun * alpha + ls;
        if (__any(alpha != 1.f)) {
#pragma unroll
            for (int dt = 0; dt < 4; ++dt) o[dt] *= alpha; }
        { bf16x8 pf[2][2]; pf[0][0] = nsa_pack8(p0, 0); pf[0][1] = nsa_pack8(p0, 1); pf[1][0] = nsa_pack8(p1, 0); pf[1][1] = nsa_pack8(p1, 1); nsa_pv(vbuf, pf, o, r, h); }
        if (it == nS - 1 || it == nTot - 1) {
            const float lt = lrun + __shfl_xor(lrun, 32); const float f = ((it == nS - 1) ? g1 : g2) / lt;
#pragma unroll
            for (int dt = 0; dt < 4; ++dt) {
#pragma unroll
                for (int aa = 0; aa < 4; ++aa) { const u32x2 pv = *(const GAS u32x2*)(mp + (32 * dt + 8 * aa) * 2); u32x2 wv;
                    wv.x = pg8::cvt_pk_bf16(bflo(pv.x) + o[dt][4 * aa] * f, bfhi(pv.x) + o[dt][4 * aa + 1] * f); wv.y = pg8::cvt_pk_bf16(bflo(pv.y) + o[dt][4 * aa + 2] * f, bfhi(pv.y) + o[dt][4 * aa + 3] * f);
                    *(GAS u32x2*)(mp + (32 * dt + 8 * aa) * 2) = wv; }
#pragma unroll
                for (int i = 0; i < 16; ++i) o[dt][i] = 0.f; }
            mrun = -1e30f; lrun = 0.f;
        }
        if (it + 1 < nTot) nsa_st_v(lds + (2 + ((it + 1) & 1)) * NBUF, tid, v0, v1);
        __syncthreads();
    }
#endif
}
__device__ __forceinline__ void p_nsa_f(const Args& a, LAS unsigned char* lds) {
    for (int u = blockIdx.x; u < 256; u += gridDim.x) { const int bk = u & 7, pr = u >> 3;
#pragma unroll 1
        for (int rep = 0; rep < 2; ++rep) nsa_unit(a, lds, bk >> 1, bk & 1, rep ? pr : 63 - pr); }
}
__device__ __forceinline__ void p_vtrans(const Args& a, LAS unsigned char* lds) {
    const int tid = threadIdx.x; const bf16* proj = (const bf16*)(a.ws + WS_PROJ);
    LAS bf16* sm = (LAS bf16*)lds;
    for (int it = blockIdx.x; it < 2 * 8 * 64; it += gridDim.x) {
        const int ts = it >> 9, bk = (it >> 6) & 7, kt = it & 63, b = bk >> 1, kvh = bk & 1;
        const bf16* src = proj + ((size_t)b * T + 64 * kt) * PW + (ts ? PVW : PVS) + kvh * 128;
        bf16* dst = (bf16*)(a.ws + (ts ? WS_VTW : WS_VTS)) + (size_t)(bk * 128) * VTP + 64 * kt;
        __syncthreads();
        { const int key = tid >> 3, ch = tid & 7; const bf16* p = src + (size_t)key * PW + ch * 16; const u32x4 x0 = *(const u32x4*)p, x1 = *(const u32x4*)(p + 8);
          LAS u32x4* q = (LAS u32x4*)(sm + key * 136 + ch * 16); q[0] = x0; q[1] = x1; }
        __syncthreads();
#pragma unroll
        for (int rep = 0; rep < 2; ++rep) { const int cidx = tid + rep * 512, d = cidx >> 3, kc = cidx & 7;
            unsigned short e[8];
#pragma unroll
            for (int i = 0; i < 8; ++i) e[i] = sm[(16 * (kc >> 1) + 4 * (kc & 1) + 8 * (i >> 2) + (i & 3)) * 136 + d];
            u32x4 wv; wv.x = e[0] | ((unsigned)e[1] << 16); wv.y = e[2] | ((unsigned)e[3] << 16); wv.z = e[4] | ((unsigned)e[5] << 16); wv.w = e[6] | ((unsigned)e[7] << 16);
            *(u32x4*)(dst + (size_t)d * VTP + kc * 8) = wv; }
    }
}


__device__ __forceinline__ void p0_cmp_weights(const Args& a, LAS unsigned char* lds) {
    const int lane = threadIdx.x & 63, wave = __builtin_amdgcn_readfirstlane(threadIdx.x >> 6), tid = threadIdx.x;
    LAS float* scr = (LAS float*)(lds + 65536 + wave * 8704);
    const int gw = blockIdx.x * 8 + wave, NGW = gridDim.x * 8;
    auto rm_id = [](int n) { return n; };
    bf16* W1T = (bf16*)(a.ws + WS_CW1T); bf16* W2T = (bf16*)(a.ws + WS_CW2T);
    for (int it = gw; it < 4 * 256 + 4 * 8; it += NGW) {
        if (it < 1024) { const int lk = it >> 8, r = it & 255, l = lk >> 1, kind = lk & 1;
            transpose_item(a.in[kind ? I_CW1V : I_CW1K] + (size_t)l * 4096 * 256, 4096, 256, W1T + (size_t)lk * 256 * VTP, scr, r, lane, rm_id, VTP); }
        else { const int r2 = it - 1024, lk = r2 >> 3, r = r2 & 7, l = lk >> 1, kind = lk & 1;
            transpose_item(a.in[kind ? I_CW2V : I_CW2K] + (size_t)l * 256 * 128, 256, 128, W2T + (size_t)lk * 128 * 256, scr, r, lane, rm_id); }
    }
    float* cpart = (float*)(a.ws + WS_CPART);
    LAS float* red = (LAS float*)lds;
    for (int it = blockIdx.x; it < 128; it += gridDim.x) {
        const int lk = it >> 5, sl = it & 31, l = lk >> 1, kind = lk & 1, n = tid & 255, kh = tid >> 8;
        const float* pe = a.in[kind ? I_CPV : I_CPK] + (size_t)l * 4096; const float* w1 = a.in[kind ? I_CW1V : I_CW1K] + (size_t)l * 4096 * 256;
        float s = 0.f;
#pragma unroll 8
        for (int kk = 0; kk < 64; ++kk) { const int k = sl * 128 + kh * 64 + kk; s += pe[k] * w1[(size_t)k * 256 + n]; }
        __syncthreads(); red[tid] = s; __syncthreads();
        if (tid < 256) cpart[(lk * 32 + sl) * 256 + tid] = red[tid] + red[tid + 256];
    }
}
template <int L> __device__ __forceinline__ void p_cmp1_f(const Args& a, LAS unsigned char* lds) {
    const int lane = threadIdx.x & 63, wave = __builtin_amdgcn_readfirstlane(threadIdx.x >> 6), r = lane & 31, hh = lane >> 5;
    const gcp projU = uniform_ptr(a.ws + WS_PROJ);
    LAS float* red = (LAS float*)lds;
    for (int u = blockIdx.x; u < 256; u += gridDim.x) {
        const int kind = u >> 7, rt = (u >> 2) & 31, nt = u & 3, lk = L * 2 + kind;
        unsigned aoff[2], woff[2];
#pragma unroll
        for (int h2 = 0; h2 < 2; ++h2) { const int row = rt * 64 + h2 * 32 + r, bh = row >> 8, c = row & 255, cc = c < 255 ? c : 254;
            aoff[h2] = (unsigned)((((bh >> 1) * T + 16 * cc) * PW + (kind ? PVC : PKC) + (bh & 1) * 128 + 8 * hh) * 2);
            woff[h2] = (unsigned)(((64 * nt + 32 * h2 + r) * VTP + 8 * hh) * 2); }
        const gcp w1U = uniform_ptr((const bf16*)(a.ws + WS_CW1T) + (size_t)lk * 256 * VTP);
        f32x16 acc[2][2];
        { const float* cpart = (const float*)(a.ws + WS_CPART) + (size_t)lk * 32 * 256 + (size_t)(4 * wave) * 256;
#pragma unroll
          for (int ch = 0; ch < 2; ++ch)
#pragma unroll
              for (int aa = 0; aa < 4; ++aa) { const int n0 = 64 * nt + 32 * ch + 8 * aa + 4 * hh;
                  const f32x4 bs = (*(const f32x4*)(cpart + n0) + *(const f32x4*)(cpart + 256 + n0)) + (*(const f32x4*)(cpart + 512 + n0) + *(const f32x4*)(cpart + 768 + n0));
#pragma unroll
                  for (int i = 0; i < 4; ++i) { acc[0][ch][4 * aa + i] = bs[i]; acc[1][ch][4 * aa + i] = bs[i]; } } }
#pragma unroll 1
        for (int lb = 0; lb < 4; ++lb) {
            const unsigned la = (unsigned)((4 * wave + lb) * PW * 2), lw = (unsigned)((4 * wave + lb) * 128 * 2);
            bf16x8 bqv[8][2], a0v[8][2];
#pragma unroll
            for (int kk = 0; kk < 8; ++kk)
#pragma unroll
                for (int h2 = 0; h2 < 2; ++h2) { bqv[kk][h2] = gld<bf16x8>(projU + (aoff[h2] + la + (unsigned)(kk * 32))); a0v[kk][h2] = gld<bf16x8>(w1U + (woff[h2] + lw + (unsigned)(kk * 32))); }
            __builtin_amdgcn_sched_barrier(0);
#pragma unroll
            for (int kk = 0; kk < 8; ++kk)
#pragma unroll
                for (int rh = 0; rh < 2; ++rh)
#pragma unroll
                    for (int ch = 0; ch < 2; ++ch) acc[rh][ch] = __builtin_amdgcn_mfma_f32_32x32x16_bf16(a0v[kk][ch], bqv[kk][rh], acc[rh][ch], 0, 0, 0);
            __builtin_amdgcn_sched_barrier(0);
        }
#define CMP1_DUMP(slot, rh) do { _Pragma("unroll") for (int ch = 0; ch < 2; ++ch) _Pragma("unroll") for (int i = 0; i < 16; ++i) red[(((slot) * 4 + (rh) * 2 + ch) * 16 + i) * 64 + lane] = acc[rh][ch][i]; } while (0)
#define CMP1_ADD(slot, rh) do { _Pragma("unroll") for (int ch = 0; ch < 2; ++ch) _Pragma("unroll") for (int i = 0; i < 16; ++i) acc[rh][ch][i] += red[(((slot) * 4 + (rh) * 2 + ch) * 16 + i) * 64 + lane]; } while (0)
        __syncthreads();
        if (wave >= 4) { CMP1_DUMP(wave - 4, 0); CMP1_DUMP(wave - 4, 1); }
        __syncthreads();
        if (wave < 4) { CMP1_ADD(wave, 0); CMP1_ADD(wave, 1); }
        if (wave == 2 || wave == 3) { CMP1_DUMP(wave, 0); CMP1_DUMP(wave, 1); }
        __syncthreads();
        if (wave < 2) { CMP1_ADD(wave + 2, 0); CMP1_ADD(wave + 2, 1); }
        if (wave == 0) CMP1_DUMP(0, 1);
        if (wave == 1) CMP1_DUMP(1, 0);
        __syncthreads();
        if (wave < 2) {
            if (wave == 0) CMP1_ADD(1, 0); else CMP1_ADD(0, 1);
            const int row = rt * 64 + wave * 32 + r, c = row & 255;
            bf16* hid = (bf16*)(a.ws + WS_CHIDB) + ((size_t)kind * NCR + row) * 256 + 64 * nt + 4 * hh;
#pragma unroll
            for (int ch = 0; ch < 2; ++ch)
#pragma unroll
                for (int aa = 0; aa < 4; ++aa) { float o4[4];
#pragma unroll
                    for (int i = 0; i < 4; ++i) { const float v = wave == 0 ? acc[0][ch][4 * aa + i] : acc[1][ch][4 * aa + i]; o4[i] = c < 255 ? gelu_tanh(v) : 0.f; }
                    u32x2 wv; wv.x = pg8::cvt_pk_bf16(o4[0], o4[1]); wv.y = pg8::cvt_pk_bf16(o4[2], o4[3]); *(u32x2*)(hid + 32 * ch + 8 * aa) = wv; }
        }
        __syncthreads();
#undef CMP1_DUMP
#undef CMP1_ADD
    }
}
template <int L> __device__ __forceinline__ void p_cmp2_f(const Args& a) {
    const int lane = threadIdx.x & 63, wave = __builtin_amdgcn_readfirstlane(threadIdx.x >> 6), r = lane & 31, hh = lane >> 5;
    const int gw = wave * gridDim.x + blockIdx.x, NGW = gridDim.x * 8;
    float* KC = (float*)(a.ws + WS_KC); bf16* KCB = (bf16*)(a.ws + WS_KCB); bf16* VCT = (bf16*)(a.ws + WS_VCT);
    for (int u = gw; u < 128; u += NGW) {
        const int kind = u >> 6, rt = u & 63, lk = L * 2 + kind, row = rt * 32 + r;
        const bf16* hp = (const bf16*)(a.ws + WS_CHIDB) + ((size_t)kind * NCR + row) * 256 + 8 * hh;
        const bf16* w2 = (const bf16*)(a.ws + WS_CW2T) + (size_t)lk * 128 * 256 + (size_t)r * 256 + 8 * hh;
        f32x16 acc[4];
#pragma unroll
        for (int dt = 0; dt < 4; ++dt)
#pragma unroll
            for (int i = 0; i < 16; ++i) acc[dt][i] = 0.f;
#pragma unroll 1
        for (int kq = 0; kq < 4; ++kq) { bf16x8 bqv[4], afv[4][4];
#pragma unroll
            for (int k4 = 0; k4 < 4; ++k4) { const int ks = 4 * kq + k4; bqv[k4] = *(const bf16x8*)(hp + 16 * ks);
#pragma unroll
                for (int dt = 0; dt < 4; ++dt) afv[k4][dt] = *(const bf16x8*)(w2 + (size_t)dt * 32 * 256 + 16 * ks); }
            __builtin_amdgcn_sched_barrier(0);
#pragma unroll
            for (int k4 = 0; k4 < 4; ++k4)
#pragma unroll
                for (int dt = 0; dt < 4; ++dt) acc[dt] = __builtin_amdgcn_mfma_f32_32x32x16_bf16(afv[k4][dt], bqv[k4], acc[dt], 0, 0, 0);
            __builtin_amdgcn_sched_barrier(0); }
#pragma unroll
        for (int dt = 0; dt < 4; ++dt)
#pragma unroll
            for (int aa = 0; aa < 4; ++aa) { const int d0 = 32 * dt + 8 * aa + 4 * hh; const f32x4 v = (f32x4){acc[dt][4 * aa], acc[dt][4 * aa + 1], acc[dt][4 * aa + 2], acc[dt][4 * aa + 3]};
                *(f32x4*)(KC + ((size_t)kind * NCR + row) * 128 + d0) = v;
                if (kind == 0) st_bf4(KCB + (size_t)row * 128 + d0, v);
                else { const int cpos = (row & 240) + vperm16(row & 15); bf16* vp = VCT + (size_t)((row >> 8) * 128 + d0) * 256 + cpos; vp[0] = (bf16)f2bf(v.x); vp[256] = (bf16)f2bf(v.y); vp[512] = (bf16)f2bf(v.z); vp[768] = (bf16)f2bf(v.w); } }
    }
}
template <int L, bool WITH_LA> __device__ __forceinline__ void p_rope_la(const Args& a) {
    bf16* proj = (bf16*)(a.ws + WS_PROJ);
    const float* rope = (const float*)(a.ws + WS_ROPE);
    const int gt = blockIdx.x * 512 + threadIdx.x, NGT = gridDim.x * 512;
    for (int idx = gt; idx < M * 64; idx += NGT) {
        const int i = idx & 15, hh = (idx >> 4) & 1, ts = (idx >> 5) & 1, m = idx >> 6, t = m & (T - 1);
        bf16* p = proj + (size_t)m * PW + (ts ? PKW : PKS) + hh * 128 + i;
        const float x1 = bf1(p[0]), x2 = bf1(p[16]), c = rope[t * 32 + i], s = rope[t * 32 + 16 + i];
        p[0] = (bf16)f2bf(x1 * c - x2 * s); p[16] = (bf16)f2bf(x2 * c + x1 * s);
    }
    float* LA = (float*)(a.ws + WS_LA);
    const float* wa2 = a.in[I_GWA2] + (size_t)L * 16 * 512; const float* ba = a.in[I_GBA] + (size_t)L * 512;
    if (WITH_LA)
    for (int idx = gt; idx < M * 512; idx += NGT) {
        const int hd = idx & 511, m = idx >> 9; const bf16* ga = proj + (size_t)m * PW + PGA;
        float z = ba[hd];
#pragma unroll
        for (int r = 0; r < 16; ++r) z += bf1(ga[r]) * wa2[r * 512 + hd];
        const float ls = fminf(z, 0.f) - log1pf(__expf(-fabsf(z)));
        LA[idx] = ls * (1.f / 16.f);
    }
}


constexpr size_t WS_HS = 484 * MiB;
constexpr size_t WS_SSB = WS_GLAO;
constexpr size_t WS_DEC = 11 * MiB;
static_assert(WS_HS + (size_t)16 * 64 * 256 * 128 * 4 <= WS_HPERM, "HS inside the free overlay");
constexpr int G_QROW = 136, G_VROW = 264;
__device__ __forceinline__ bf16x8 lds_gather8(const LAS bf16* p, int stride) {
    const unsigned e0 = p[0], e1 = p[stride], e2 = p[2 * stride], e3 = p[3 * stride], e4 = p[4 * stride], e5 = p[5 * stride], e6 = p[6 * stride], e7 = p[7 * stride];
    u32x4 w; w.x = e0 | (e1 << 16); w.y = e2 | (e3 << 16); w.z = e4 | (e5 << 16); w.w = e6 | (e7 << 16); return __builtin_bit_cast(bf16x8, w);
}
__device__ __forceinline__ void gla_stage_v(gcp projU, unsigned rowoff0, int h, LAS bf16* VS, int tid) {
    const int j = tid >> 3, ch = tid & 7;
    const gcp p = projU + (rowoff0 + (unsigned)((j * PW + PGV + h * 256 + ch * 32) * 2));
    const u32x4 x0 = gld<u32x4>(p), x1 = gld<u32x4>(p + 16), x2 = gld<u32x4>(p + 32), x3 = gld<u32x4>(p + 48);
    LAS u32x4* q = (LAS u32x4*)(VS + j * G_VROW + ch * 32); q[0] = x0; q[1] = x1; q[2] = x2; q[3] = x3;
}
template <int L> __device__ __forceinline__ void p_gla1(const Args& a, LAS unsigned char* lds) {
    const int tid = threadIdx.x, lane = tid & 63, w = __builtin_amdgcn_readfirstlane(tid >> 6), r = lane & 31, hh = lane >> 5;
    LAS bf16* KS = (LAS bf16*)lds; LAS bf16* VS = (LAS bf16*)(lds + 18432); LAS float* qt = (LAS float*)(lds + 18432 + 33792); LAS u32x4* GIN = (LAS u32x4*)(lds + 18432 + 33792 + 2048);
    const gcp projU = uniform_ptr(a.ws + WS_PROJ);
    float* BC = (float*)(a.ws + WS_LA); bf16* HS = (bf16*)(a.ws + WS_HS); float* DEC = (float*)(a.ws + WS_DEC);
    const float* wa2 = a.in[I_GWA2] + (size_t)L * 16 * 512; const float* ba = a.in[I_GBA] + (size_t)L * 512;
    const int d = tid & 127, jq = tid >> 7;
    u32x4 pv[4], pga; unsigned short pk[16];
    auto issue = [&](int u) {
        const int bh = u >> 6, c = u & 63, b = bh >> 2, h = bh & 3, m0 = b * T + c * 64;
        const unsigned rowoff0 = (unsigned)m0 * (unsigned)(PW * 2);
        { const int j = tid >> 3, ch = tid & 7; const gcp p = projU + (rowoff0 + (unsigned)((j * PW + PGV + h * 256 + ch * 32) * 2));
          pv[0] = gld<u32x4>(p); pv[1] = gld<u32x4>(p + 16); pv[2] = gld<u32x4>(p + 32); pv[3] = gld<u32x4>(p + 48); }
        pga = gld<u32x4>(projU + (rowoff0 + (unsigned)((((tid & 127) >> 1) * PW + PGA) * 2 + (tid & 1) * 16)));
#pragma unroll
        for (int i = 0; i < 16; ++i) pk[i] = gld<bf16>(projU + (rowoff0 + (unsigned)(((jq * 16 + i) * PW + PGK + h * 128 + d) * 2)));
    };
    int hprev = -1; float wv[16]; float bias = 0.f;
    if ((int)blockIdx.x < 1024) issue(blockIdx.x);
    for (int u = blockIdx.x; u < 1024; u += gridDim.x) {
        const int bh = u >> 6, c = u & 63, b = bh >> 2, h = bh & 3, m0 = b * T + c * 64;
        if (h != hprev) { hprev = h;
#pragma unroll
            for (int rr = 0; rr < 16; ++rr) wv[rr] = wa2[rr * 512 + h * 128 + d];
            bias = ba[h * 128 + d]; }
        __syncthreads();
        { const int j = tid >> 3, ch = tid & 7; LAS u32x4* q = (LAS u32x4*)(VS + j * G_VROW + ch * 32); q[0] = pv[0]; q[1] = pv[1]; q[2] = pv[2]; q[3] = pv[3]; }
        if (tid < 128) GIN[tid] = pga;
        float kraw[16];
#pragma unroll
        for (int i = 0; i < 16; ++i) kraw[i] = bf1(pk[i]);
        __syncthreads();
        { float pre[16]; float run = 0.f;
#pragma unroll
          for (int i = 0; i < 16; ++i) { const u32x4 g0 = GIN[(jq * 16 + i) * 2], g1 = GIN[(jq * 16 + i) * 2 + 1];
              float z = bias + bflo(g0.x) * wv[0] + bfhi(g0.x) * wv[1] + bflo(g0.y) * wv[2] + bfhi(g0.y) * wv[3] + bflo(g0.z) * wv[4] + bfhi(g0.z) * wv[5] + bflo(g0.w) * wv[6] + bfhi(g0.w) * wv[7]
                      + bflo(g1.x) * wv[8] + bfhi(g1.x) * wv[9] + bflo(g1.y) * wv[10] + bfhi(g1.y) * wv[11] + bflo(g1.z) * wv[12] + bfhi(g1.z) * wv[13] + bflo(g1.w) * wv[14] + bfhi(g1.w) * wv[15];
              const float la = (fminf(z, 0.f) - __logf(1.f + __expf(-fabsf(z)))) * (1.f / 16.f); run += la; pre[i] = run; }
          qt[jq * 128 + d] = run;
          __syncthreads();
          float off = 0.f, tot = 0.f;
#pragma unroll
          for (int q = 0; q < 4; ++q) { const float v = qt[q * 128 + d]; off += (q < jq) ? v : 0.f; tot += v; }
          float ksv[16];
#pragma unroll
          for (int i = 0; i < 16; ++i) { const int j = jq * 16 + i; const float bj = off + pre[i];
              BC[(size_t)(m0 + j) * 512 + h * 128 + d] = bj;
              ksv[i] = kraw[i] * __expf(tot - bj); }
          { u32x4 w0, w1; w0.x = pk2(ksv[0], ksv[1]); w0.y = pk2(ksv[2], ksv[3]); w0.z = pk2(ksv[4], ksv[5]); w0.w = pk2(ksv[6], ksv[7]); w1.x = pk2(ksv[8], ksv[9]); w1.y = pk2(ksv[10], ksv[11]); w1.z = pk2(ksv[12], ksv[13]); w1.w = pk2(ksv[14], ksv[15]);
            LAS u32x4* kq = (LAS u32x4*)(KS + d * 72 + jq * 16); kq[0] = w0; kq[1] = w1; }
          if (jq == 0) DEC[(size_t)(bh * 64 + c) * 128 + d] = __expf(tot); }
        __syncthreads();
        if (u + (int)gridDim.x < 1024) issue(u + gridDim.x);
        __builtin_amdgcn_sched_barrier(0);
        f32x16 acc[4];
#pragma unroll
        for (int dt = 0; dt < 4; ++dt)
#pragma unroll
            for (int i = 0; i < 16; ++i) acc[dt][i] = 0.f;
#pragma unroll
        for (int ks = 0; ks < 4; ++ks) { const bf16x8 bq = lds_gather8(VS + (16 * ks + 8 * hh) * G_VROW + 32 * w + r, G_VROW); bf16x8 afv[4];
#pragma unroll
            for (int dt = 0; dt < 4; ++dt) afv[dt] = *(const LAS bf16x8*)(KS + (32 * dt + r) * 72 + 16 * ks + 8 * hh);
            __builtin_amdgcn_sched_barrier(0);
#pragma unroll
            for (int dt = 0; dt < 4; ++dt) acc[dt] = __builtin_amdgcn_mfma_f32_32x32x16_bf16(afv[dt], bq, acc[dt], 0, 0, 0);
            __builtin_amdgcn_sched_barrier(0); }
        bf16* hp = HS + ((size_t)(bh * 64 + c) * 256 + 32 * w + r) * 128 + 4 * hh;
#pragma unroll
        for (int dt = 0; dt < 4; ++dt)
#pragma unroll
            for (int aa = 0; aa < 4; ++aa) st_bf4(hp + 32 * dt + 8 * aa, (f32x4){acc[dt][4 * aa], acc[dt][4 * aa + 1], acc[dt][4 * aa + 2], acc[dt][4 * aa + 3]});
    }
}
__device__ __forceinline__ void p_gla2(const Args& a) {
    const bf16* HS = (const bf16*)(a.ws + WS_HS); const float* DEC = (const float*)(a.ws + WS_DEC); bf16* SSB = (bf16*)(a.ws + WS_SSB);
    for (int idx = blockIdx.x * 512 + threadIdx.x; idx < 16 * 256 * 32; idx += gridDim.x * 512) {
        const int bh = idx >> 13, e = (idx >> 5) & 255, d4 = idx & 31;
        f32x4 S = (f32x4){0.f, 0.f, 0.f, 0.f};
        u32x2 hA[8], hB[8]; f32x4 dA[8], dB[8];
#define GLA2_LD(H, Dc, C0) do { _Pragma("unroll") for (int i = 0; i < 8; ++i) { H[i] = *(const u32x2*)(HS + ((size_t)(bh * 64 + (C0) + i) * 256 + e) * 128 + d4 * 4); Dc[i] = *(const f32x4*)(DEC + (size_t)(bh * 64 + (C0) + i) * 128 + d4 * 4); } } while (0)
#define GLA2_ST(H, Dc, C0) do { _Pragma("unroll") for (int i = 0; i < 8; ++i) { st_bf4(SSB + ((size_t)(bh * 64 + (C0) + i) * 256 + e) * 128 + d4 * 4, S); S = S * Dc[i] + (f32x4){bflo(H[i].x), bfhi(H[i].x), bflo(H[i].y), bfhi(H[i].y)}; } } while (0)
        GLA2_LD(hA, dA, 0);
#pragma unroll 1
        for (int c0 = 0; c0 < 64; c0 += 16) {
            GLA2_LD(hB, dB, c0 + 8); __builtin_amdgcn_sched_barrier(0);
            GLA2_ST(hA, dA, c0); __builtin_amdgcn_sched_barrier(0);
            if (c0 + 16 < 64) GLA2_LD(hA, dA, c0 + 16);
            __builtin_amdgcn_sched_barrier(0);
            GLA2_ST(hB, dB, c0 + 8); __builtin_amdgcn_sched_barrier(0);
        }
#undef GLA2_LD
#undef GLA2_ST
    }
}
template <int L> __device__ __forceinline__ void p_gla3(const Args& a, LAS unsigned char* lds) {
    const int tid = threadIdx.x, lane = tid & 63, w = __builtin_amdgcn_readfirstlane(tid >> 6), r = lane & 31, hh = lane >> 5;
    LAS bf16* QD = (LAS bf16*)lds; LAS bf16* KI = (LAS bf16*)(lds + 17408); LAS bf16* VS = (LAS bf16*)(lds + 34816); LAS float* part = (LAS float*)(lds + 34816 + 33792);
    const gcp projU = uniform_ptr(a.ws + WS_PROJ);
    const float* BC = (const float*)(a.ws + WS_LA); const bf16* SSB = (const bf16*)(a.ws + WS_SSB); bf16* mix = (bf16*)(a.ws + WS_MIX);
    const float* nw = a.in[I_GNW] + (size_t)L * 256;
    const int ih = w & 1;
    for (int u = blockIdx.x; u < 1024; u += gridDim.x) {
        const int bh = u >> 6, c = u & 63, b = bh >> 2, h = bh & 3, m0 = b * T + c * 64;
        const unsigned rowoff0 = (unsigned)m0 * (unsigned)(PW * 2);
        __syncthreads();
        bf16x8 sfr[2][8];
        { const int j = tid >> 3, dg = tid & 7, ch = tid & 7;
          const gcp vp0 = projU + (rowoff0 + (unsigned)((j * PW + PGV + h * 256 + ch * 32) * 2));
          const u32x4 x0 = gld<u32x4>(vp0), x1 = gld<u32x4>(vp0 + 16), x2 = gld<u32x4>(vp0 + 32), x3 = gld<u32x4>(vp0 + 48);
          const gcp qp = projU + (rowoff0 + (unsigned)((j * PW + PGQ + h * 128 + dg * 16) * 2)); const gcp kp = projU + (rowoff0 + (unsigned)((j * PW + PGK + h * 128 + dg * 16) * 2));
          const float* bp = BC + (size_t)(m0 + j) * 512 + h * 128 + dg * 16;
          u32x4 qrv[2], krv[2]; f32x4 b0v[2], b1v[2];
#pragma unroll
          for (int hf = 0; hf < 2; ++hf) { qrv[hf] = gld<u32x4>(qp + 16 * hf); krv[hf] = gld<u32x4>(kp + 16 * hf); b0v[hf] = *(const f32x4*)(bp + 8 * hf); b1v[hf] = *(const f32x4*)(bp + 8 * hf + 4); }
#pragma unroll
          for (int t2 = 0; t2 < 2; ++t2) { const bf16* sp = SSB + ((size_t)(bh * 64 + c) * 256 + 32 * ((w >> 1) * 2 + t2) + r) * 128 + 8 * hh;
#pragma unroll
              for (int ks = 0; ks < 8; ++ks) sfr[t2][ks] = *(const bf16x8*)(sp + 16 * ks); }
          __builtin_amdgcn_sched_barrier(0);
          { LAS u32x4* q = (LAS u32x4*)(VS + j * G_VROW + ch * 32); q[0] = x0; q[1] = x1; q[2] = x2; q[3] = x3; }
          u32x4 qo[2], ko[2];
#pragma unroll
          for (int hf = 0; hf < 2; ++hf) { const u32x4 qr = qrv[hf], kr = krv[hf]; const f32x4 b0 = b0v[hf], b1 = b1v[hf];
              const float bv[8] = {b0.x, b0.y, b0.z, b0.w, b1.x, b1.y, b1.z, b1.w};
#pragma unroll
              for (int i = 0; i < 4; ++i) { const float e0 = __expf(bv[2 * i]), e1 = __expf(bv[2 * i + 1]);
                  qo[hf][i] = pg8::cvt_pk_bf16(bflo(qr[i]) * QSCALE * e0, bfhi(qr[i]) * QSCALE * e1); ko[hf][i] = pg8::cvt_pk_bf16(bflo(kr[i]) * __builtin_amdgcn_rcpf(e0), bfhi(kr[i]) * __builtin_amdgcn_rcpf(e1)); } }
          LAS u32x4* qd = (LAS u32x4*)(QD + j * G_QROW + dg * 16); qd[0] = qo[0]; qd[1] = qo[1];
          LAS u32x4* kd = (LAS u32x4*)(KI + j * G_QROW + dg * 16); kd[0] = ko[0]; kd[1] = ko[1]; }
        __syncthreads();
        const int mi = m0 + 32 * ih + r;
        u32x2 ggv[2][4]; f32x4 w4v[2][4];
#pragma unroll
        for (int t2 = 0; t2 < 2; ++t2)
#pragma unroll
            for (int aa = 0; aa < 4; ++aa) { const int e0 = 32 * ((w >> 1) * 2 + t2) + 8 * aa + 4 * hh; ggv[t2][aa] = gld<u32x2>(projU + ((unsigned)mi * (unsigned)(PW * 2) + (unsigned)((PGG + h * 256 + e0) * 2))); w4v[t2][aa] = *(const f32x4*)(nw + e0); }
        __builtin_amdgcn_sched_barrier(0);
        bf16x8 qdf[8];
#pragma unroll
        for (int ks = 0; ks < 8; ++ks) qdf[ks] = *(const LAS bf16x8*)(QD + (32 * ih + r) * G_QROW + 16 * ks + 8 * hh);
        bf16x8 pf[2][2];
#pragma unroll
        for (int jh = 0; jh < 2; ++jh) { f32x16 X;
#pragma unroll
            for (int i = 0; i < 16; ++i) X[i] = 0.f;
            if (jh <= ih) {
#pragma unroll
                for (int kq = 0; kq < 2; ++kq) { bf16x8 afx[4];
#pragma unroll
                    for (int k4 = 0; k4 < 4; ++k4) afx[k4] = *(const LAS bf16x8*)(KI + (32 * jh + r) * G_QROW + 16 * (4 * kq + k4) + 8 * hh);
                    __builtin_amdgcn_sched_barrier(0);
#pragma unroll
                    for (int k4 = 0; k4 < 4; ++k4) X = __builtin_amdgcn_mfma_f32_32x32x16_bf16(afx[k4], qdf[4 * kq + k4], X, 0, 0, 0);
                    __builtin_amdgcn_sched_barrier(0); }
#pragma unroll
                for (int i = 0; i < 16; ++i) { const int jj = 32 * jh + (i & 3) + 8 * (i >> 2) + 4 * hh; X[i] = (jj <= 32 * ih + r) ? X[i] : 0.f; } }
            pf[jh][0] = nsa_pack8(X, 0); pf[jh][1] = nsa_pack8(X, 1); }
        f32x16 o2[2];
#pragma unroll
        for (int t2 = 0; t2 < 2; ++t2) { const int et = (w >> 1) * 2 + t2;
#pragma unroll
            for (int i = 0; i < 16; ++i) o2[t2][i] = 0.f;
#pragma unroll
            for (int jh = 0; jh < 2; ++jh) if (jh <= ih) {
#pragma unroll
                for (int ss = 0; ss < 2; ++ss) { const LAS bf16* vp = VS + (32 * jh + 16 * ss + 4 * hh) * G_VROW + 32 * et + r;
                    const unsigned e0 = vp[0], e1 = vp[G_VROW], e2 = vp[2 * G_VROW], e3 = vp[3 * G_VROW], e4 = vp[8 * G_VROW], e5 = vp[9 * G_VROW], e6 = vp[10 * G_VROW], e7 = vp[11 * G_VROW];
                    u32x4 wv; wv.x = e0 | (e1 << 16); wv.y = e2 | (e3 << 16); wv.z = e4 | (e5 << 16); wv.w = e6 | (e7 << 16);
                    o2[t2] = __builtin_amdgcn_mfma_f32_32x32x16_bf16(__builtin_bit_cast(bf16x8, wv), pf[jh][ss], o2[t2], 0, 0, 0); } }
#pragma unroll
            for (int ks = 0; ks < 8; ++ks) o2[t2] = __builtin_amdgcn_mfma_f32_32x32x16_bf16(sfr[t2][ks], qdf[ks], o2[t2], 0, 0, 0);
            __builtin_amdgcn_sched_barrier(0); }
        float ss = 0.f;
#pragma unroll
        for (int t2 = 0; t2 < 2; ++t2)
#pragma unroll
            for (int i = 0; i < 16; ++i) ss += o2[t2][i] * o2[t2][i];
        ss += __shfl_xor(ss, 32);
        if (hh == 0) part[(w >> 1) * 64 + 32 * ih + r] = ss;
        __syncthreads();
        const float tot = (part[32 * ih + r] + part[64 + 32 * ih + r]) + (part[128 + 32 * ih + r] + part[192 + 32 * ih + r]);
        const float rinv = 1.f / sqrtf(tot * (1.f / 256.f) + NORM_EPS);
#pragma unroll
        for (int t2 = 0; t2 < 2; ++t2) { const int et = (w >> 1) * 2 + t2;
#pragma unroll
            for (int aa = 0; aa < 4; ++aa) { const int e0 = 32 * et + 8 * aa + 4 * hh;
                const u32x2 ggw = ggv[t2][aa]; const f32x4 gg = (f32x4){bflo(ggw.x), bfhi(ggw.x), bflo(ggw.y), bfhi(ggw.y)}; const f32x4 w4 = w4v[t2][aa];
                f32x4 y; y.x = o2[t2][4 * aa] * rinv * w4.x * siluf_(gg.x); y.y = o2[t2][4 * aa + 1] * rinv * w4.y * siluf_(gg.y); y.z = o2[t2][4 * aa + 2] * rinv * w4.z * siluf_(gg.z); y.w = o2[t2][4 * aa + 3] * rinv * w4.w * siluf_(gg.w);
                st_bf4(mix + (size_t)mi * 2048 + 1024 + h * 256 + e0, y); } }
    }
}

template <int L> __device__ __forceinline__ void p_inproj_f(const Args& a, LAS unsigned char* lds) {
    pg8::Gemm g{(const bf16*)(a.ws + WS_HB), (const bf16*)(a.ws + WS_WIN_T) + (size_t)L * PW * D, M, PW, D}; pg8::StaticOrder S; S.init(M, PW, gridDim.x, blockIdx.x);
    EpiStoreBf16 E{(bf16*)(a.ws + WS_PROJ), PW};
    pg8::gemm_phase<EpiStoreBf16, pg8::StaticOrder, PG8_ALIGN, PG8_SP2>(lds, g, S, E);
}
#if XBF16
#define EPI_RESID(XF32) EpiResidB<XF32>
#define EPI_RESID_XIN(p) ((const void*)(p))
#else
#define EPI_RESID(XF32) EpiResid
#define EPI_RESID_XIN(p) ((const float*)(p))
#endif
template <int L, bool XF32> __device__ __forceinline__ void p_outproj_f(const Args& a, LAS unsigned char* lds, const void* xin, XT* xout) {
    pg8::Gemm g{(const bf16*)(a.ws + WS_MIX), (const bf16*)(a.ws + WS_WOUT_T) + (size_t)L * D * D, M, D, D}; pg8::StaticOrder S; S.init(M, D, gridDim.x, blockIdx.x);
    EPI_RESID(XF32) E{EPI_RESID_XIN(xin), xout, (const float*)(a.ws + WS_MOD) + (size_t)L * 4 * D6 + 4096, 1.f};
    pg8::gemm_phase<EPI_RESID(XF32), pg8::StaticOrder, PG8_ALIGN, PG8_SP2>(lds, g, S, E);
}
__device__ __forceinline__ void p_ffn_gateup_f(const Args& a, LAS unsigned char* lds) {
    if (FFN8_GU) { pg8::Gemm g{(const bf16*)(a.ws + WS_HB), (const bf16*)(a.ws + WS_FGU_T), M, 2 * DFF, D / 2}; pg8::StaticOrder S; S.init(M, 2 * DFF, gridDim.x, blockIdx.x);
        if (FFN8_DN) { EpiSwiglu8 E{a.ws + WS_HID, DFF, 1.f / F8_WGU}; pg8::gemm_phase<EpiSwiglu8, pg8::StaticOrder, PG8_ALIGN, PG8_SP2, true>(lds, g, S, E); }
        else { EpiSwiglu E{(bf16*)(a.ws + WS_HID), DFF, 1.f / F8_WGU}; pg8::gemm_phase<EpiSwiglu, pg8::StaticOrder, PG8_ALIGN, PG8_SP2, true>(lds, g, S, E); }
        return; }
    pg8::Gemm g{(const bf16*)(a.ws + WS_HB), (const bf16*)(a.ws + WS_FGU_T), M, 2 * DFF, D}; pg8::StaticOrder S; S.init(M, 2 * DFF, gridDim.x, blockIdx.x);
    if (FFN8_DN) { EpiSwiglu8 E{a.ws + WS_HID, DFF, 1.f}; pg8::gemm_phase<EpiSwiglu8, pg8::StaticOrder, PG8_ALIGN, PG8_SP2>(lds, g, S, E); }
    else { EpiSwiglu E{(bf16*)(a.ws + WS_HID), DFF, 1.f}; pg8::gemm_phase<EpiSwiglu, pg8::StaticOrder, PG8_ALIGN, PG8_SP2>(lds, g, S, E); }
}
template <int L> __device__ __forceinline__ void p_ffn_down_f(const Args& a, LAS unsigned char* lds, const XT* X, XT* xout) {
    if (FFN8_DN) { pg8::Gemm g{(const bf16*)(a.ws + WS_HID), (const bf16*)(a.ws + WS_FD_T), M, D, DFF / 2}; pg8::StaticOrder S; S.init(M, D, gridDim.x, blockIdx.x);
        EPI_RESID(false) E{EPI_RESID_XIN(X), xout, (const float*)(a.ws + WS_MOD) + (size_t)L * 4 * D6 + 10240, 1.f / F8_FD};
        pg8::gemm_phase<EPI_RESID(false), pg8::StaticOrder, PG8_ALIGN, PG8_SP2, true>(lds, g, S, E); return; }
    pg8::Gemm g{(const bf16*)(a.ws + WS_HID), (const bf16*)(a.ws + WS_FD_T), M, D, DFF}; pg8::StaticOrder S; S.init(M, D, gridDim.x, blockIdx.x);
    EPI_RESID(false) E{EPI_RESID_XIN(X), xout, (const float*)(a.ws + WS_MOD) + (size_t)L * 4 * D6 + 10240, 1.f};
    pg8::gemm_phase<EPI_RESID(false), pg8::StaticOrder, PG8_ALIGN, PG8_SP2>(lds, g, S, E);
}
__device__ __forceinline__ void p_moe_gateup_f(const Args& a, LAS unsigned char* lds) {
    const int* moe_base = (const int*)(a.ws + WS_ROUTE + 512 * 1024);
    if (MOE_FP8) { pg8::Gemm g{(const bf16*)(a.ws + WS_HPERM), (const bf16*)(a.ws + WS_MGU_T), MOE_ROWS, 2 * DFE, D / 2}; MoeOrder S; S.init(moe_base, 2 * DFE, gridDim.x, blockIdx.x);
        EpiSwiglu8 E{a.ws + WS_HID, DFE, 1.f / F8_WGU};
        pg8::gemm_phase<EpiSwiglu8, MoeOrder, PG8_ALIGN, PG8_SP2, true>(lds, g, S, E); return; }
    pg8::Gemm g{(const bf16*)(a.ws + WS_HPERM), (const bf16*)(a.ws + WS_MGU_T), MOE_ROWS, 2 * DFE, D}; MoeOrder S; S.init(moe_base, 2 * DFE, gridDim.x, blockIdx.x);
    EpiSwiglu E{(bf16*)(a.ws + WS_HID), DFE, 1.f};
    pg8::gemm_phase<EpiSwiglu, MoeOrder, PG8_ALIGN, PG8_SP2>(lds, g, S, E);
}
__device__ __forceinline__ void p_moe_down_f(const Args& a, LAS unsigned char* lds) {
    const int* moe_base = (const int*)(a.ws + WS_ROUTE + 512 * 1024);
    if (MOE_FP8) { pg8::Gemm g{(const bf16*)(a.ws + WS_HID), (const bf16*)(a.ws + WS_MD_T), MOE_ROWS, D, DFE / 2}; MoeOrder S; S.init(moe_base, D, gridDim.x, blockIdx.x);
        EpiBf16S E{(bf16*)(a.ws + WS_Y), D, 1.f / F8_WD};
        pg8::gemm_phase<EpiBf16S, MoeOrder, PG8_ALIGN, PG8_SP2, true>(lds, g, S, E); return; }
    pg8::Gemm g{(const bf16*)(a.ws + WS_HID), (const bf16*)(a.ws + WS_MD_T), MOE_ROWS, D, DFE}; MoeOrder S; S.init(moe_base, D, gridDim.x, blockIdx.x);
    EpiF32 E{(float*)(a.ws + WS_Y), D};
    pg8::gemm_phase<EpiF32, MoeOrder, PG8_ALIGN, PG8_SP2>(lds, g, S, E);
}

constexpr int NPHASE = 25;

__global__ void __launch_bounds__(512, 2) mk_fwd(Args a) {
    extern __shared__ __attribute__((aligned(16))) unsigned char lds_raw[];
    LAS unsigned char* lds = (LAS unsigned char*)lds_raw;
    volatile LAS unsigned* MISC = (volatile LAS unsigned*)(lds + MISC_OFF);
    if (threadIdx.x < 64) MISC[threadIdx.x] = 0u;
    __syncthreads();
    const int lo = a.ph_lo, hi = a.ph_hi;
#if ONE_LAUNCH
    XcdBarrier bar = xcd_barrier_post((unsigned*)(a.ws + WS_CTL) + CW_BAR, MISC + 8);
#define SEAM(k) do { if (lo <= (k) && (k) + 1 < hi) xcd_barrier(bar); } while (0)
#else
#define SEAM(k) do { } while (0)
#endif
#ifndef PHMASK
#define PHMASK 0xFFFFFFFFu
#endif
#define IN(k) (((PHMASK >> (k)) & 1u) && lo <= (k) && (k) < hi)
#ifndef DBLMASK
#define DBLMASK 0u
#endif
#define DBL(k) ((((unsigned)DBLMASK >> (k)) & 1u) != 0u)
#ifndef DBLSUB
#define DBLSUB 0u
#endif
#define DSUB(b) ((((unsigned)DBLSUB >> (b)) & 1u) != 0u)
    static_assert(!XBF16 || FAST_GEMM, "the bf16 residual stream is wired through the fast GEMM phases only");
    XT* XA = (XT*)(a.ws + WS_XA);
    XT* XB = XBF16 ? (XT*)(a.ws + WS_XA + (size_t)M * D * 2) : (XT*)a.out;
    const float* MOD = (const float*)(a.ws + WS_MOD);
    if (IN(0)) { p0_mod(a, lds); if (FAST_GEMM) p0_weights(a, lds); if (FAST_CMP) p0_cmp_weights(a, lds); if (DBL(0)) { p0_mod(a, lds); if (FAST_GEMM) p0_weights(a, lds); if (FAST_CMP) p0_cmp_weights(a, lds); } } SEAM(0);
    if (IN(1)) { if (FAST_GEMM) p_mod_rows(a, a.in[I_X], MOD, MOD + 2048); if (DBL(1)) { if (FAST_GEMM) p_mod_rows(a, a.in[I_X], MOD, MOD + 2048); } } SEAM(1);
    if (IN(2)) { if (FAST_GEMM) p_inproj_f<0>(a, lds); else p_inproj_g<0>(a, lds, a.in[I_X]); if (DBL(2)) { if (FAST_GEMM) p_inproj_f<0>(a, lds); else p_inproj_g<0>(a, lds, a.in[I_X]); } } SEAM(2);
    if (IN(3)) { if (FAST_CMP) { p_cmp1_f<0>(a, lds); p_rope_la<0, FAST_GLA == 0>(a); } else p_cmp1_g<0>(a, lds); if (FAST_NSA) p_vtrans(a, lds); if (FAST_GLA) p_gla1<0>(a, lds); if (DSUB(2)) p_gla1<0>(a, lds); if (DSUB(0)) p_cmp1_f<0>(a, lds); if (DSUB(1)) p_vtrans(a, lds); if (DBL(3)) { if (FAST_CMP) { p_cmp1_f<0>(a, lds);  } else p_cmp1_g<0>(a, lds); if (FAST_NSA) p_vtrans(a, lds); if (FAST_GLA) p_gla1<0>(a, lds); } } SEAM(3);
    if (IN(4)) { if (FAST_CMP) p_cmp2_f<0>(a); else p_cmp2_g<0>(a, lds); if (FAST_GLA) p_gla2(a); if (DBL(4)) { if (FAST_CMP) p_cmp2_f<0>(a); else p_cmp2_g<0>(a, lds); if (FAST_GLA) p_gla2(a); } } SEAM(4);
    if (IN(5)) { if (FAST_NSA) p_nsa_f(a, lds); else p_nsa_g(a, lds); if (FAST_GLA) p_gla3<0>(a, lds); if (DSUB(4)) p_nsa_f(a, lds); if (DSUB(5)) p_gla3<0>(a, lds); if (DBL(5)) { if (FAST_NSA) p_nsa_f(a, lds); else p_nsa_g(a, lds); if (FAST_GLA) p_gla3<0>(a, lds); } } SEAM(5);
    if (!FAST_GLA) { if (IN(6)) { p_gla_g(a); if (DBL(6)) { p_gla_g(a); } } SEAM(6);
    if (IN(7)) { p_glapost<0>(a); if (DBL(7)) { p_glapost<0>(a); } } SEAM(7); }
    if (IN(8)) { if (FAST_GEMM) p_outproj_f<0, true>(a, lds, a.in[I_X], XA); else p_outproj_g<0>(a, lds, a.in[I_X], (float*)XA); if (DBL(8)) { if (FAST_GEMM) p_outproj_f<0, true>(a, lds, a.in[I_X], XA); else p_outproj_g<0>(a, lds, a.in[I_X], (float*)XA); } } SEAM(8);
    if (IN(9)) { p_ln_mix<0, false, FAST_GEMM != 0>(a, lds, XA); if (DBL(9)) { p_ln_mix<0, false, FAST_GEMM != 0>(a, lds, XA); } } SEAM(9);
    if (IN(10)) { if (FAST_GEMM) p_ffn_gateup_f(a, lds); else p_ffn_gateup_g<0>(a, lds, (float*)XA); if (DBL(10)) { if (FAST_GEMM) p_ffn_gateup_f(a, lds); else p_ffn_gateup_g<0>(a, lds, (float*)XA); } } SEAM(10);
    if (IN(11)) { if (FAST_GEMM) p_ffn_down_f<0>(a, lds, XA, XB); else p_ffn_down_g<0>(a, lds, (float*)XA, a.out); if (DBL(11)) { if (FAST_GEMM) p_ffn_down_f<0>(a, lds, XA, XB); else p_ffn_down_g<0>(a, lds, (float*)XA, a.out); } } SEAM(11);
    if (IN(12)) { p_ln_ffn<0, FAST_GEMM != 0>(a, XB); if (DBL(12)) { p_ln_ffn<0, FAST_GEMM != 0>(a, XB); } } SEAM(12);
    if (IN(13)) { if (FAST_GEMM) p_inproj_f<1>(a, lds); else p_inproj_g<1>(a, lds, a.out); if (DBL(13)) { if (FAST_GEMM) p_inproj_f<1>(a, lds); else p_inproj_g<1>(a, lds, a.out); } } SEAM(13);
    if (IN(14)) { if (FAST_CMP) { p_cmp1_f<1>(a, lds); p_rope_la<1, FAST_GLA == 0>(a); } else p_cmp1_g<1>(a, lds); if (FAST_NSA) p_vtrans(a, lds); if (FAST_GLA) p_gla1<1>(a, lds); if (DSUB(2)) p_gla1<1>(a, lds); if (DSUB(0)) p_cmp1_f<1>(a, lds); if (DSUB(1)) p_vtrans(a, lds); if (DBL(14)) { if (FAST_CMP) { p_cmp1_f<1>(a, lds);  } else p_cmp1_g<1>(a, lds); if (FAST_NSA) p_vtrans(a, lds); if (FAST_GLA) p_gla1<1>(a, lds); } } SEAM(14);
    if (IN(15)) { if (FAST_CMP) p_cmp2_f<1>(a); else p_cmp2_g<1>(a, lds); if (FAST_GLA) p_gla2(a); if (DBL(15)) { if (FAST_CMP) p_cmp2_f<1>(a); else p_cmp2_g<1>(a, lds); if (FAST_GLA) p_gla2(a); } } SEAM(15);
    if (IN(16)) { if (FAST_NSA) p_nsa_f(a, lds); else p_nsa_g(a, lds); if (FAST_GLA) p_gla3<1>(a, lds); if (DSUB(4)) p_nsa_f(a, lds); if (DSUB(5)) p_gla3<1>(a, lds); if (DBL(16)) { if (FAST_NSA) p_nsa_f(a, lds); else p_nsa_g(a, lds); if (FAST_GLA) p_gla3<1>(a, lds); } } SEAM(16);
    if (!FAST_GLA) { if (IN(17)) { p_gla_g(a); if (DBL(17)) { p_gla_g(a); } } SEAM(17);
    if (IN(18)) { p_glapost<1>(a); if (DBL(18)) { p_glapost<1>(a); } } SEAM(18); }
    if (IN(19)) { if (FAST_GEMM) p_outproj_f<1, XBF16 == 0>(a, lds, XB, XA); else p_outproj_g<1>(a, lds, a.out, (float*)XA); if (DBL(19)) { if (FAST_GEMM) p_outproj_f<1, XBF16 == 0>(a, lds, XB, XA); else p_outproj_g<1>(a, lds, a.out, (float*)XA); } } SEAM(19);
    if (IN(20)) { p_ln_mix<1, true, false>(a, lds, XA); if (DBL(20)) { p_ln_mix<1, true, false>(a, lds, XA); } } SEAM(20);
    if (IN(21)) { p_moe_slots<1>(a, lds, XA); if (DBL(21)) { p_moe_slots<1>(a, lds, XA); } } SEAM(21);
    if (IN(22)) { if (FAST_GEMM) p_moe_gateup_f(a, lds); else p_moe_gateup_g(a, lds); if (DBL(22)) { if (FAST_GEMM) p_moe_gateup_f(a, lds); else p_moe_gateup_g(a, lds); } } SEAM(22);
    if (IN(23)) { if (FAST_GEMM) p_moe_down_f(a, lds); else p_moe_down_g(a, lds); if (DBL(23)) { if (FAST_GEMM) p_moe_down_f(a, lds); else p_moe_down_g(a, lds); } } SEAM(23);
    if (IN(24)) { p_moe_combine_ln<1>(a, XA, a.out); }
#undef IN
#undef SEAM
}

extern "C" void kernel_launch(void* const* d_in, const int* in_sizes, int n_in, void* d_out, int out_size, void* d_ws, size_t ws_size, hipStream_t stream) {
    static int grid = 0;
    if (grid == 0) {
        if (n_in != 26 || out_size != M * D || ws_size < WS_END3) { fprintf(stderr, "kernel_launch: unexpected shapes (n_in %d out %d ws %zu)\n", n_in, out_size, ws_size); grid = -1; return; }
        int dev = 0, cus = 0;
        if (hipGetDevice(&dev) != hipSuccess || hipDeviceGetAttribute(&cus, hipDeviceAttributeMultiprocessorCount, dev) != hipSuccess) { grid = -1; return; }
        if (hipFuncSetAttribute((const void*)mk_fwd, hipFuncAttributeMaxDynamicSharedMemorySize, LDS_BYTES) != hipSuccess) { fprintf(stderr, "kernel_launch: hipFuncSetAttribute failed\n"); grid = -1; return; }
        int per_cu = 0;
        if (hipOccupancyMaxActiveBlocksPerMultiprocessor(&per_cu, (const void*)mk_fwd, 512, LDS_BYTES) != hipSuccess || per_cu < 1) { fprintf(stderr, "kernel_launch: occupancy query says %d\n", per_cu); }
        (void)hipGetLastError();
        grid = cus;
    }
    if (grid < 0) return;
    (void)hipMemsetAsync((char*)d_ws + WS_CTL, 0, CTL_ZERO_BYTES, stream);
    Args a{};
    for (int i = 0; i < 26; ++i) a.in[i] = (const float*)d_in[i];
    a.out = (float*)d_out; a.ws = (unsigned char*)d_ws; a.pad0 = 0; a.pad1 = 0;
#if ONE_LAUNCH
    a.ph_lo = 0; a.ph_hi = NPHASE;
    hipLaunchKernelGGL(mk_fwd, dim3(grid), dim3(512), LDS_BYTES, stream, a);
#else
#ifndef HOST_DBLMASK
#define HOST_DBLMASK 0u
#endif
    for (int ph = 0; ph < NPHASE; ++ph) {
        a.ph_lo = ph; a.ph_hi = ph + 1;
        for (int rep = 0; rep < ((((unsigned)HOST_DBLMASK >> ph) & 1u) ? 2 : 1); ++rep)
            hipLaunchKernelGGL(mk_fwd, dim3(grid), dim3(512), LDS_BYTES, stream, a);
    }
#endif
}
```
